# Optimizing an MI355X kernel written in HIP

```python
import math
import jax, jax.numpy as jnp
from jax import lax
import numpy as np

D_MODEL = 1024
BATCH = 32
SEQ = 2048
DEPTH = 2

CHUNK = 64
HEAD_DIM = 64
N_MIX_HEADS = D_MODEL // HEAD_DIM
ATT_HEADS = N_MIX_HEADS // 4
RWKV_HEADS = (N_MIX_HEADS - ATT_HEADS) // 2
RET_HEADS = N_MIX_HEADS - ATT_HEADS - RWKV_HEADS
RWKV_W = RWKV_HEADS * HEAD_DIM
RET_W = RET_HEADS * HEAD_DIM
ATT_W = ATT_HEADS * HEAD_DIM
D_MIX = RWKV_W + RET_W + ATT_W

DECAY_LORA = 64
AAA_LORA = 64
GATE_LORA = 128
RWKV_SPLITS = (RWKV_W, RWKV_W, RWKV_W, DECAY_LORA, AAA_LORA, GATE_LORA)
RWKV_COLS = sum(RWKV_SPLITS)
RET_COLS = 4 * RET_W
ATT_COLS = 3 * ATT_W
N_IN_COLS = RWKV_COLS + RET_COLS + ATT_COLS

BAND_PREV_CHUNKS = 8
BAND = (BAND_PREV_CHUNKS + 1) * CHUNK
REL_CLIP = 128
REL_TABLE = (CHUNK - 1) + REL_CLIP + 1

D_FF = 256 * ((8 * D_MODEL // 3 + 255) // 256)
CONV_W = 3

ALPHA = (2 * DEPTH) ** 0.25
BETA = (8 * DEPTH) ** -0.25
ROPE_BASE = 10000.0
LN_EPS = 1e-5
RWKV_GN_EPS = 64e-5
RET_GN_EPS = 1e-5

kernel_name = "hybrid_rwkv7_retnet_chunkattn_deepnorm"


def _offsets(sizes):
    out, acc = [], 0
    for s in sizes[:-1]:
        acc += s
        out.append(acc)
    return out


def layer_norm(x, g, b, eps=LN_EPS):
    xf = x.astype(jnp.float32)
    mu = jnp.mean(xf, axis=-1, keepdims=True)
    var = jnp.mean(jnp.square(xf - mu), axis=-1, keepdims=True)
    y = (xf - mu) * lax.rsqrt(var + eps) * g.astype(jnp.float32) + b.astype(jnp.float32)
    return y.astype(x.dtype)


def head_norm(y, g, b, eps):
    H, d = y.shape[-2], y.shape[-1]
    mu = jnp.mean(y, axis=-1, keepdims=True)
    var = jnp.mean(jnp.square(y - mu), axis=-1, keepdims=True)
    yn = (y - mu) * lax.rsqrt(var + eps)
    return yn * g.astype(jnp.float32).reshape(H, d) + b.astype(jnp.float32).reshape(H, d)


def token_shift(z, mu):
    prev = jnp.pad(z, ((0, 0), (1, 0), (0, 0)))[:, :-1]
    return z + (prev - z) * mu


def rope(t, pos):
    half = t.shape[-1] // 2
    inv = ROPE_BASE ** (-jnp.arange(half, dtype=jnp.float32) / half)
    ang = pos[:, None] * inv[None, :]
    cos = jnp.cos(ang)[:, None, :]
    sin = jnp.sin(ang)[:, None, :]
    t1, t2 = t[..., :half], t[..., half:]
    return jnp.concatenate([t1 * cos - t2 * sin, t1 * sin + t2 * cos], axis=-1)


def rwkv7_time_mix(z, mu, w0, w_up, a0, a_up, g_up, k_k, k_a, r_k, ln_g, ln_b):
    B, S, _ = z.shape
    H, N = RWKV_HEADS, HEAD_DIM
    f32 = jnp.float32
    z = token_shift(z.astype(f32), mu.astype(f32))
    r, k, v, wl, al, gl = jnp.split(z, _offsets(RWKV_SPLITS), axis=-1)
    w_raw = -jax.nn.softplus(-(w0.astype(f32) + jnp.tanh(wl) @ w_up.astype(f32))) - 0.5
    decay = jnp.exp(-jnp.exp(w_raw))
    a = jax.nn.sigmoid(a0.astype(f32) + al @ a_up.astype(f32))
    g = jax.nn.sigmoid(gl) @ g_up.astype(f32)

    def heads(t):
        return t.reshape(B, S, H, N)

    kk = heads(k * k_k.astype(f32))
    kk = kk / jnp.maximum(jnp.sqrt(jnp.sum(kk * kk, axis=-1, keepdims=True)), 1e-12)
    k = heads(k * (1.0 + (a - 1.0) * k_a.astype(f32)))
    r, v, decay, a = heads(r), heads(v), heads(decay), heads(a)
    a_vec = -kk
    b_vec = kk * a

    def step(state, inp):
        r_t, w_t, k_t, v_t, a_t, b_t = inp
        sa = jnp.einsum('bhvk,bhk->bhv', state, a_t)
        state = (state * w_t[:, :, None, :] + sa[..., None] * b_t[:, :, None, :]
                 + v_t[..., None] * k_t[:, :, None, :])
        return state, jnp.einsum('bhvk,bhk->bhv', state, r_t)

    xs = tuple(jnp.moveaxis(t, 1, 0) for t in (r, decay, k, v, a_vec, b_vec))
    _, y = lax.scan(step, jnp.zeros((B, H, N, N), f32), xs)
    y = jnp.moveaxis(y, 0, 1)
    bonus = jnp.sum(r * k * r_k.astype(f32), axis=-1, keepdims=True) * v
    y = head_norm(y, ln_g, ln_b, RWKV_GN_EPS) + bonus
    return y.reshape(B, S, RWKV_W) * g


def retention_mix(z, gn_g, gn_b):
    B, S, _ = z.shape
    H, d, C = RET_HEADS, HEAD_DIM, CHUNK
    nc = S // C
    f32 = jnp.float32
    q, k, v, g = jnp.split(z.astype(f32), [RET_W, 2 * RET_W, 3 * RET_W], axis=-1)
    pos = jnp.arange(S, dtype=f32)
    q = rope(q.reshape(B, S, H, d), pos)
    k = rope(k.reshape(B, S, H, d), pos) * (d ** -0.5)
    v = v.reshape(B, S, H, d)
    log_g = jnp.log(1.0 - jnp.exp2(-5.0 - jnp.arange(H, dtype=f32)))
    q = q.reshape(B, nc, C, H, d)
    k = k.reshape(B, nc, C, H, d)
    v = v.reshape(B, nc, C, H, d)
    idx = jnp.arange(C, dtype=f32)
    dmat = jnp.exp(log_g[:, None, None] * jnp.abs(idx[:, None] - idx[None, :]))
    scores = jnp.einsum('bnihd,bnjhd->bnhij', q, k) * dmat
    intra = jnp.einsum('bnhij,bnjhe->bnihe', scores, v)
    k_dec = jnp.exp(log_g[None, :] * (C - 1.0 - idx)[:, None])
    u = jnp.einsum('bnjhd,bnjhe->nbhde', k * k_dec[None, None, :, :, None], v)
    chunk_decay = jnp.exp(log_g * C)[None, :, None, None]

    def step(state, u_n):
        return state * chunk_decay + u_n, state

    _, r_prev = lax.scan(step, jnp.zeros((B, H, d, d), f32), u)
    q_dec = jnp.exp(log_g[None, :] * (idx + 1.0)[:, None])
    inter = jnp.einsum('bnihd,nbhde->bnihe', q, r_prev) * q_dec[None, None, :, :, None]
    y = (intra + inter).reshape(B, S, H, d)
    y = head_norm(y, gn_g, gn_b, RET_GN_EPS).reshape(B, S, RET_W)
    return y * jax.nn.silu(g)


def chunk_band_attention(z, rel_bias):
    B, S, _ = z.shape
    H, d, C = ATT_HEADS, HEAD_DIM, CHUNK
    nc = S // C
    pad = BAND_PREV_CHUNKS * C
    f32 = jnp.float32
    q, k, v = jnp.split(z.astype(f32), [ATT_W, 2 * ATT_W], axis=-1)
    q = q.reshape(B, S, H, d) * (d ** -0.5)
    k_pad = jnp.pad(k.reshape(B, S, H, d), ((0, 0), (pad, 0), (0, 0), (0, 0)))
    v_pad = jnp.pad(v.reshape(B, S, H, d), ((0, 0), (pad, 0), (0, 0), (0, 0)))
    i = jnp.arange(C)
    j = jnp.arange(BAND)
    rel = (i[:, None] + pad) - j[None, :]
    rel_idx = jnp.clip(rel, -(C - 1), REL_CLIP) + (C - 1)
    bias = rel_bias.astype(f32)[:, rel_idx]

    def one_chunk(n):
        start = n * C
        q_n = lax.dynamic_slice_in_dim(q, start, C, axis=1)
        k_n = lax.dynamic_slice_in_dim(k_pad, start, BAND, axis=1)
        v_n = lax.dynamic_slice_in_dim(v_pad, start, BAND, axis=1)
        s = jnp.einsum('bihd,bjhd->bhij', q_n, k_n) + bias[None]
        valid = (start + j) >= pad
        s = jnp.where(valid[None, None, None, :], s, -1e30)
        p = jax.nn.softmax(s, axis=-1)
        return jnp.einsum('bhij,bjhd->bihd', p, v_n)

    out = lax.map(one_chunk, jnp.arange(nc))
    return jnp.moveaxis(out, 0, 1).reshape(B, S, ATT_W)


def conv_gated_ffn(x, w_up, conv_w, conv_b, w_down):
    S = x.shape[1]
    u = x @ w_up
    u_pad = jnp.pad(u, ((0, 0), (CONV_W - 1, 0), (0, 0)))
    c = conv_b
    for t in range(CONV_W):
        c = c + conv_w[t] * u_pad[:, t:t + S]
    gate, val = jnp.split(c, 2, axis=-1)
    return (jax.nn.silu(gate) * val) @ w_down


def setup_inputs(seed: int = 0) -> dict:
    key = jax.random.key(seed)
    ks = jax.random.split(key, 32)
    f32 = jnp.float32
    nrm = lambda k, s: jax.random.normal(k, s, f32)
    L = DEPTH
    return {
        "x": nrm(ks[0], (BATCH, SEQ, D_MODEL)),
        "ln_in_g": 1.0 + 0.02 * nrm(ks[1], (D_MODEL,)),
        "ln_in_b": 0.02 * nrm(ks[2], (D_MODEL,)),
        "w_in": nrm(ks[3], (L, D_MODEL, N_IN_COLS)) * D_MODEL ** -0.5,
        "rw_mu": jax.random.uniform(ks[4], (L, RWKV_COLS), f32),
        "rw_w0": jax.random.uniform(ks[5], (L, RWKV_W), f32, minval=-6.0, maxval=-1.0),
        "rw_w_up": nrm(ks[6], (L, DECAY_LORA, RWKV_W)) * 0.5 * DECAY_LORA ** -0.5,
        "rw_a0": 0.1 * nrm(ks[7], (L, RWKV_W)),
        "rw_a_up": nrm(ks[8], (L, AAA_LORA, RWKV_W)) * AAA_LORA ** -0.5,
        "rw_g_up": nrm(ks[9], (L, GATE_LORA, RWKV_W)) * GATE_LORA ** -0.5,
        "rw_k_k": 0.85 + 0.05 * nrm(ks[10], (L, RWKV_W)),
        "rw_k_a": 1.0 + 0.05 * nrm(ks[11], (L, RWKV_W)),
        "rw_r_k": 0.1 * nrm(ks[12], (L, RWKV_HEADS, HEAD_DIM)),
        "rw_ln_g": 1.0 + 0.02 * nrm(ks[13], (L, RWKV_W)),
        "rw_ln_b": 0.02 * nrm(ks[14], (L, RWKV_W)),
        "ret_gn_g": 1.0 + 0.02 * nrm(ks[15], (L, RET_W)),
        "ret_gn_b": 0.02 * nrm(ks[16], (L, RET_W)),
        "attn_rel_bias": 0.1 * nrm(ks[17], (L, ATT_HEADS, REL_TABLE)),
        "w_out": nrm(ks[18], (L, D_MIX, D_MODEL)) * D_MIX ** -0.5 * BETA,
        "ln1_g": 1.0 + 0.02 * nrm(ks[19], (L, D_MODEL)),
        "ln1_b": 0.02 * nrm(ks[20], (L, D_MODEL)),
        "ffn_w_up": nrm(ks[21], (L, D_MODEL, 2 * D_FF)) * D_MODEL ** -0.5,
        "ffn_conv_w": nrm(ks[22], (L, CONV_W, 2 * D_FF)) * CONV_W ** -0.5,
        "ffn_conv_b": 0.02 * nrm(ks[23], (L, 2 * D_FF)),
        "ffn_w_down": nrm(ks[24], (L, D_FF, D_MODEL)) * D_FF ** -0.5 * BETA,
        "ln2_g": 1.0 + 0.02 * nrm(ks[25], (L, D_MODEL)),
        "ln2_b": 0.02 * nrm(ks[26], (L, D_MODEL)),
    }


def reference(x, ln_in_g, ln_in_b, w_in, rw_mu, rw_w0, rw_w_up, rw_a0, rw_a_up, rw_g_up,
              rw_k_k, rw_k_a, rw_r_k, rw_ln_g, rw_ln_b, ret_gn_g, ret_gn_b, attn_rel_bias,
              w_out, ln1_g, ln1_b, ffn_w_up, ffn_conv_w, ffn_conv_b, ffn_w_down, ln2_g, ln2_b):
    x = layer_norm(x, ln_in_g, ln_in_b)
    for l in range(DEPTH):
        z = x @ w_in[l]
        z_rwkv = z[..., :RWKV_COLS]
        z_ret = z[..., RWKV_COLS:RWKV_COLS + RET_COLS]
        z_att = z[..., RWKV_COLS + RET_COLS:]
        y_rwkv = rwkv7_time_mix(z_rwkv, rw_mu[l], rw_w0[l], rw_w_up[l], rw_a0[l], rw_a_up[l],
                                rw_g_up[l], rw_k_k[l], rw_k_a[l], rw_r_k[l], rw_ln_g[l], rw_ln_b[l])
        y_ret = retention_mix(z_ret, ret_gn_g[l], ret_gn_b[l])
        y_att = chunk_band_attention(z_att, attn_rel_bias[l])
        y = jnp.concatenate([y_rwkv, y_ret, y_att], axis=-1).astype(x.dtype)
        x = layer_norm(ALPHA * x + y @ w_out[l], ln1_g[l], ln1_b[l])
        f = conv_gated_ffn(x, ffn_w_up[l], ffn_conv_w[l], ffn_conv_b[l], ffn_w_down[l])
        x = layer_norm(ALPHA * x + f.astype(x.dtype), ln2_g[l], ln2_b[l])
    return x
```

```cpp
#include <hip/hip_runtime.h>
#include <hip/hip_cooperative_groups.h>
#include <cstdio>
#include <cstdint>
namespace cg = cooperative_groups;

#define LAS __attribute__((address_space(3)))
typedef unsigned short bf16;
typedef short bf16x8 __attribute__((ext_vector_type(8)));
typedef float f32x4 __attribute__((ext_vector_type(4)));
typedef float f32x2 __attribute__((ext_vector_type(2)));
typedef unsigned u32x4 __attribute__((ext_vector_type(4)));
typedef unsigned u32x2 __attribute__((ext_vector_type(2)));

constexpr int NB = 32, SEQ = 2048, DM = 1024, MTOK = NB * SEQ;
constexpr int ZR_P = 1536, ZT_P = 1536, ZA_P = 768, LP_P = 1536, Y_P = 1024, KP_P = 1024;
constexpr int NIN = 3712, NIN_PAD = 3840, DFF = 2816, DFF2 = 5632, NLORA = 1280, KLORA = 256;
constexpr int MHALF = MTOK / 2;
constexpr float ALPHA = 1.41421356237309515f;
constexpr float LN_EPS = 1e-5f;

constexpr size_t MiB = 1u << 20;
constexpr size_t WS_CTL = 0;
constexpr size_t WS_ROPEC = 1 * MiB, WS_ROPES = WS_ROPEC + 256 * 1024, WS_GPOW = WS_ROPES + 256 * 1024;
constexpr size_t WS_W = 2 * MiB, W_LAYER = 27 * MiB;
constexpr size_t WO_IN = 0, WO_OUT = WO_IN + (size_t)NIN_PAD * DM * 2, WO_UP = WO_OUT + (size_t)DM * DM * 2,
                 WO_DN = WO_UP + (size_t)DFF2 * DM * 2, WO_LORA = WO_DN + (size_t)DM * DFF * 2, WO_END = WO_LORA + (size_t)NLORA * KLORA * 2;
static_assert(WO_END <= W_LAYER, "weights per layer");
constexpr size_t WS_XN = 64 * MiB, WS_Y = 192 * MiB, WS_ZR = 320 * MiB, WS_ZT = 512 * MiB, WS_ZA = 704 * MiB, WS_LP = 800 * MiB, WS_BONUS = 992 * MiB;
constexpr size_t WS_U = 320 * MiB, WS_HH = 672 * MiB, WS_END = 1024 * MiB;
static_assert(WS_U + (size_t)MHALF * DFF2 * 2 <= WS_HH && WS_HH + (size_t)MHALF * DFF * 2 <= WS_END, "ffn map");

constexpr int LDS_BYTES = 147456;
constexpr int MISC_OFF = 131072;

namespace pg8 {
constexpr int BM = 256, BK = 64, HALF = 128, HTB = HALF * BK * 2, NXCD = 8, WGM = 8;
__host__ __device__ __forceinline__ int lds_byte(int r, int c) { const int st = (r >> 4) * 2 + (c >> 5), rr = r & 15, cc = c & 31, ob = rr * 64 + cc * 2; return st * 1024 + (ob ^ (((ob >> 9) & 1) << 5)); }
__host__ __device__ __forceinline__ void stage_rc(int b, int& R, int& C) { const int st = b / 1024, sb = b % 1024, swz = sb ^ (((sb >> 9) & 1) << 5); R = (st >> 1) * 16 + swz / 64; C = (st & 1) * 32 + (swz % 64) / 2; }
__host__ __device__ __forceinline__ int perm32(int rho) { const int n = rho >> 4, i = rho & 15; return 8 * (i >> 2) + 4 * n + (i & 3); }
struct Unit { int pm, pn; };
struct Gemm { const bf16* A; const bf16* Bt; int M, N, K, lda; };
struct StaticOrder {
    int nM, nN, nwg, G, c;
    __device__ void init(int M, int N, int G_, int c_) { nM = M / BM; nN = N / BM; nwg = nM * nN; G = G_; c = c_; }
    __device__ bool next(int i, Unit& u) const {
        const long L = (long)i * G + c; if (L >= nwg) return false;
        int wgid = (int)L; { const int q = nwg / NXCD, r = nwg % NXCD, xcd = wgid % NXCD, off = wgid / NXCD; wgid = (xcd < r ? xcd * (q + 1) : r * (q + 1) + (xcd - r) * q) + off; }
        const int nig = WGM * nN, gid = wgid / nig, fm = gid * WGM, gsz = (nM - fm) < WGM ? (nM - fm) : WGM;
        u.pm = fm + ((wgid % nig) % gsz); u.pn = (wgid % nig) / gsz; return true;
    }
};
__device__ __forceinline__ unsigned cvt_pk_bf16(float lo, float hi) { unsigned r; asm volatile("v_cvt_pk_bf16_f32 %0, %1, %2" : "=v"(r) : "v"(lo), "v"(hi)); return r; }

struct EpiBf16 {
    static constexpr bool PERM = true;
    bf16* O; int ldc;
    __device__ __forceinline__ void operator()(const f32x4 (&acc)[2][2][4][2], const Unit& u, int wr, int wc, int fr, int fq) const {
        const int row0 = u.pm * BM + wr * 64 + fr, col0 = u.pn * BM + wc * 32 + 8 * fq;
#pragma unroll
        for (int ai = 0; ai < 2; ++ai)
#pragma unroll
            for (int m = 0; m < 4; ++m) { bf16* rowp = O + (size_t)(row0 + ai * HALF + m * 16) * ldc + col0;
#pragma unroll
                for (int bj = 0; bj < 2; ++bj) { const f32x4 v0 = acc[ai][bj][m][0], v1 = acc[ai][bj][m][1];
                    u32x4 w; w.x = cvt_pk_bf16(v0[0], v0[1]); w.y = cvt_pk_bf16(v0[2], v0[3]); w.z = cvt_pk_bf16(v1[0], v1[1]); w.w = cvt_pk_bf16(v1[2], v1[3]);
                    *(u32x4*)(rowp + bj * HALF) = w; } }
    }
};
struct EpiZ {
    static constexpr bool PERM = true;
    bf16 *Zr, *Zt, *Za;
    __device__ __forceinline__ void operator()(const f32x4 (&acc)[2][2][4][2], const Unit& u, int wr, int wc, int fr, int fq) const {
        bf16* base; int ldc, colt; float sc = 1.f;
        if (u.pn < 6) { base = Zr; ldc = ZR_P; colt = u.pn * BM; } else if (u.pn < 12) { base = Zt; ldc = ZT_P; colt = (u.pn - 6) * BM; } else { base = Za; ldc = ZA_P; colt = (u.pn - 12) * BM; if (u.pn == 12) sc = 0.125f; }
        const int row0 = u.pm * BM + wr * 64 + fr, col0 = colt + wc * 32 + 8 * fq;
#pragma unroll
        for (int ai = 0; ai < 2; ++ai)
#pragma unroll
            for (int m = 0; m < 4; ++m) { bf16* rowp = base + (size_t)(row0 + ai * HALF + m * 16) * ldc + col0;
#pragma unroll
                for (int bj = 0; bj < 2; ++bj) { const f32x4 v0 = acc[ai][bj][m][0] * sc, v1 = acc[ai][bj][m][1] * sc;
                    u32x4 w; w.x = cvt_pk_bf16(v0[0], v0[1]); w.y = cvt_pk_bf16(v0[2], v0[3]); w.z = cvt_pk_bf16(v1[0], v1[1]); w.w = cvt_pk_bf16(v1[2], v1[3]);
                    *(u32x4*)(rowp + bj * HALF) = w; } }
    }
};
struct EpiRes {
    static constexpr bool PERM = false;
    float* X; float alpha;
    __device__ __forceinline__ void operator()(const f32x4 (&acc)[2][2][4][2], const Unit& u, int wr, int wc, int fr, int fq) const {
        const int row0 = u.pm * BM + wr * 64 + fr, col0 = u.pn * BM + wc * 32 + 4 * fq;
#pragma unroll
        for (int ai = 0; ai < 2; ++ai)
#pragma unroll
            for (int m = 0; m < 4; ++m) { float* rowp = X + (size_t)(row0 + ai * HALF + m * 16) * DM + col0;
#pragma unroll
                for (int bj = 0; bj < 2; ++bj)
#pragma unroll
                    for (int n = 0; n < 2; ++n) { f32x4* p = (f32x4*)(rowp + bj * HALF + n * 16); const f32x4 x = *p; *p = x * alpha + acc[ai][bj][m][n]; } }
    }
};

template <class Epi>
__device__ __forceinline__ void gemm_phase(LAS unsigned char* lds, const Gemm g, const StaticOrder& S, const Epi& E) {
    const int tid = threadIdx.x, wid = __builtin_amdgcn_readfirstlane(tid >> 6), lane = tid & 63, wr = wid >> 2, wc = wid & 3, fr = lane & 15, fq = lane >> 4;
    const int K = g.K, nt = K / BK, lda = g.lda;
    unsigned voffA[2], voffB[2];
#pragma unroll
    for (int i = 0; i < 2; ++i) { int R, C; stage_rc(tid * 16 + i * 8192, R, C); const int Rb = Epi::PERM ? ((R & ~31) + perm32(R & 31)) : R;
        voffA[i] = (unsigned)(R * lda + C) * 2u; voffB[i] = (unsigned)(Rb * K + C) * 2u; }
    const size_t kstep = (size_t)(BK * 2);
    const size_t hstepA = (size_t)HALF * lda * 2, hstepB = (size_t)HALF * K * 2;
    const size_t tstepA = 2 * hstepA, tstepB = 2 * hstepB;
    const unsigned ldsw = (unsigned)wid * 1024u;
    const int aoff = lds_byte(wr * 64 + fr, fq * 8), boff = lds_byte(wc * 32 + fr, fq * 8);
#define PG8_SA(b, h) (((b) * 2 + (h)) * HTB)
#define PG8_SB(b, h) ((4 + (b) * 2 + (h)) * HTB)
#define PG8_STAGE(bufoff, gbase, voff) do { _Pragma("unroll") for (int _i = 0; _i < 2; ++_i) \
        __builtin_amdgcn_global_load_lds((const unsigned*)((const char*)(gbase) + (voff)[_i]), (LAS unsigned*)(lds + (bufoff) + ldsw + _i * 8192), 16, 0, 0); } while (0)
#define PG8_LDA(dst, b, h) do { _Pragma("unroll") for (int m = 0; m < 4; ++m) _Pragma("unroll") for (int k = 0; k < 2; ++k) dst[m][k] = *(const LAS bf16x8*)(lds + PG8_SA(b, h) + aoff + m * 2048 + k * 1024); } while (0)
#define PG8_LDB(dst, b, h) do { _Pragma("unroll") for (int n = 0; n < 2; ++n) _Pragma("unroll") for (int k = 0; k < 2; ++k) dst[n][k] = *(const LAS bf16x8*)(lds + PG8_SB(b, h) + boff + n * 2048 + k * 1024); } while (0)
#define PG8_MMA(ai, bj, At, Bt) do { __builtin_amdgcn_s_setprio(1); _Pragma("unroll") for (int m = 0; m < 4; ++m) _Pragma("unroll") for (int n = 0; n < 2; ++n) _Pragma("unroll") for (int k = 0; k < 2; ++k) \
        acc[ai][bj][m][n] = __builtin_amdgcn_mfma_f32_16x16x32_bf16(Bt[n][k], At[m][k], acc[ai][bj][m][n], 0, 0, 0); __builtin_amdgcn_s_setprio(0); } while (0)
#define PG8_WAIT_V(n) asm volatile("s_waitcnt vmcnt(" #n ")" ::: "memory")
#define PG8_WAIT_L(n) asm volatile("s_waitcnt lgkmcnt(" #n ")" ::: "memory")
#define PG8_BAR __builtin_amdgcn_s_barrier()
#define PG8_SCHED __builtin_amdgcn_sched_barrier(0)
    Unit cur, nxt; int ui = 0;
    if (!S.next(0, cur)) return;
    f32x4 acc[2][2][4][2];
#pragma unroll
    for (int a = 0; a < 2; ++a)
#pragma unroll
        for (int b = 0; b < 2; ++b)
#pragma unroll
            for (int m = 0; m < 4; ++m)
#pragma unroll
                for (int n = 0; n < 2; ++n) acc[a][b][m][n] = (f32x4){0.f, 0.f, 0.f, 0.f};
    bf16x8 At[4][2], B0[2][2], B1[2][2];
    const char* cA = (const char*)g.A + (size_t)cur.pm * tstepA; const char* cB = (const char*)g.Bt + (size_t)cur.pn * tstepB;
    PG8_STAGE(PG8_SB(0, 0), cB, voffB); PG8_STAGE(PG8_SB(0, 1), cB + hstepB, voffB); PG8_STAGE(PG8_SA(0, 0), cA, voffA); PG8_STAGE(PG8_SA(0, 1), cA + hstepA, voffA);
    if (wr == 1) PG8_BAR;
    PG8_WAIT_V(2); PG8_BAR;
    PG8_STAGE(PG8_SB(1, 0), cB + kstep, voffB); PG8_STAGE(PG8_SA(1, 0), cA + kstep, voffA); PG8_STAGE(PG8_SB(1, 1), cB + hstepB + kstep, voffB);
    PG8_WAIT_V(6); PG8_BAR;
    for (;;) {
        const bool has_next = S.next(ui + 1, nxt);
        const char* nA = has_next ? (const char*)g.A + (size_t)nxt.pm * tstepA : cA; const char* nB = has_next ? (const char*)g.Bt + (size_t)nxt.pn * tstepB : cB;
        for (int t = 0; t < nt; t += 2) {
            const bool last = (t == nt - 2);
            const char* a1 = cA + (size_t)(t + 1) * kstep;
            const char* a2 = last ? nA : cA + (size_t)(t + 2) * kstep; const char* b2 = last ? nB : cB + (size_t)(t + 2) * kstep;
            const char* a3 = a2 + kstep; const char* b3 = b2 + kstep;
            PG8_LDB(B0, 0, 0); PG8_LDB(B1, 0, 1); PG8_SCHED; PG8_LDA(At, 0, 0); PG8_STAGE(PG8_SA(1, 1), a1 + hstepA, voffA);
            PG8_WAIT_V(8); PG8_WAIT_L(0); PG8_BAR; PG8_MMA(0, 0, At, B0); PG8_MMA(0, 1, At, B1); PG8_BAR; PG8_SCHED;
            PG8_LDA(At, 0, 1); PG8_STAGE(PG8_SB(0, 0), b2, voffB); PG8_STAGE(PG8_SB(0, 1), b2 + hstepB, voffB); PG8_STAGE(PG8_SA(0, 0), a2, voffA);
            PG8_WAIT_V(8); PG8_WAIT_L(0); PG8_BAR; PG8_MMA(1, 0, At, B0); PG8_MMA(1, 1, At, B1); PG8_BAR; PG8_SCHED;
            PG8_LDB(B0, 1, 0); PG8_LDB(B1, 1, 1); PG8_SCHED; PG8_LDA(At, 1, 0); PG8_STAGE(PG8_SA(0, 1), a2 + hstepA, voffA);
            PG8_WAIT_V(8); PG8_WAIT_L(0); PG8_BAR; PG8_MMA(0, 0, At, B0); PG8_MMA(0, 1, At, B1); PG8_BAR; PG8_SCHED;
            PG8_LDA(At, 1, 1); PG8_STAGE(PG8_SB(1, 0), b3, voffB); PG8_STAGE(PG8_SB(1, 1), b3 + hstepB, voffB); PG8_STAGE(PG8_SA(1, 0), a3, voffA);
            PG8_WAIT_V(8); PG8_WAIT_L(0); PG8_BAR; PG8_MMA(1, 0, At, B0); PG8_MMA(1, 1, At, B1); PG8_BAR; PG8_SCHED;
        }
        if (wr == 0) PG8_BAR;
        E(acc, cur, wr, wc, fr, fq);
        if (!has_next) break;
#pragma unroll
        for (int a = 0; a < 2; ++a)
#pragma unroll
            for (int b = 0; b < 2; ++b)
#pragma unroll
                for (int m = 0; m < 4; ++m)
#pragma unroll
                    for (int n = 0; n < 2; ++n) acc[a][b][m][n] = (f32x4){0.f, 0.f, 0.f, 0.f};
        cur = nxt; cA = nA; cB = nB; ++ui;
        if (wr == 1) PG8_BAR;
    }
    PG8_WAIT_V(0);
    PG8_BAR;
#undef PG8_SA
#undef PG8_SB
#undef PG8_STAGE
#undef PG8_LDA
#undef PG8_LDB
#undef PG8_MMA
#undef PG8_WAIT_V
#undef PG8_WAIT_L
#undef PG8_BAR
#undef PG8_SCHED
}
}

__device__ __forceinline__ unsigned f2bf(float f) { unsigned u = __builtin_bit_cast(unsigned, f); return (u + 0x7fffu + ((u >> 16) & 1u)) >> 16; }
__device__ __forceinline__ unsigned pk2(float lo, float hi) { return f2bf(lo) | (f2bf(hi) << 16); }
__device__ __forceinline__ float bf2f(unsigned u) { return __builtin_bit_cast(float, u << 16); }
__device__ __forceinline__ float bflo(unsigned w) { return __builtin_bit_cast(float, w << 16); }
__device__ __forceinline__ float bfhi(unsigned w) { return __builtin_bit_cast(float, w & 0xffff0000u); }
__device__ __forceinline__ float wave_sum(float v) {
#pragma unroll
    for (int o = 1; o < 64; o <<= 1) v += __shfl_xor(v, o);
    return v;
}
__device__ __forceinline__ float row16_sum(float v) { v += __shfl_xor(v, 1); v += __shfl_xor(v, 2); v += __shfl_xor(v, 4); v += __shfl_xor(v, 8); return v; }
__device__ __forceinline__ float row16_max(float v) { v = fmaxf(v, __shfl_xor(v, 1)); v = fmaxf(v, __shfl_xor(v, 2)); v = fmaxf(v, __shfl_xor(v, 4)); v = fmaxf(v, __shfl_xor(v, 8)); return v; }
__device__ __forceinline__ float sigmoidf_(float x) { return 1.f / (1.f + __expf(-x)); }
__device__ __forceinline__ void unpack8(const u32x4 w, float (&o)[8]) { o[0] = bflo(w.x); o[1] = bfhi(w.x); o[2] = bflo(w.y); o[3] = bfhi(w.y); o[4] = bflo(w.z); o[5] = bfhi(w.z); o[6] = bflo(w.w); o[7] = bfhi(w.w); }
__device__ __forceinline__ u32x4 pack8(const float (&o)[8]) { u32x4 w; w.x = pk2(o[0], o[1]); w.y = pk2(o[2], o[3]); w.z = pk2(o[4], o[5]); w.w = pk2(o[6], o[7]); return w; }
#define LDS_WAIT() asm volatile("s_waitcnt lgkmcnt(0)" ::: "memory")

__device__ __forceinline__ int map_row(int n, int mode) {
    if (mode == 1) return n < 1408 ? n : n + 128;
    if (mode == 2) { if (n < DFF) return 256 * (n >> 7) + (n & 127); const int q = n - DFF; return 256 * (q >> 7) + 128 + (q & 127); }
    return n;
}
__device__ __forceinline__ void p0_transpose_item(const float* W, int K, int N, bf16* WT, int mode, LAS float* scr, int item, int lane) {
    const int nblk = N / 32, kb = item / nblk, nb = item % nblk, k0 = 64 * kb, n0 = 32 * nb;
#pragma unroll 8
    for (int i = 0; i < 32; ++i) { const int kk = 2 * i + (lane >> 5); scr[kk * 33 + (lane & 31)] = W[(size_t)(k0 + kk) * N + n0 + (lane & 31)]; }
    LDS_WAIT();
    const int c = lane & 7;
#pragma unroll
    for (int j = 0; j < 4; ++j) { const int n = (lane >> 3) + 8 * j; const LAS float* s = scr + (8 * c) * 33 + n;
        u32x4 o; o.x = pk2(s[0 * 33], s[1 * 33]); o.y = pk2(s[2 * 33], s[3 * 33]); o.z = pk2(s[4 * 33], s[5 * 33]); o.w = pk2(s[6 * 33], s[7 * 33]);
        *(u32x4*)(WT + (size_t)map_row(n0 + n, mode) * K + k0 + 8 * c) = o; }
    LDS_WAIT();
}
__device__ __forceinline__ void ln_row(const float* xrow, const float* g, const float* bta, float* orow, bf16* brow, int lane) {
    const f32x4* xr = (const f32x4*)xrow + lane;
    f32x4 v[4]; float s = 0.f;
#pragma unroll
    for (int j = 0; j < 4; ++j) { v[j] = xr[64 * j]; s += (v[j].x + v[j].y) + (v[j].z + v[j].w); }
    const float mean = wave_sum(s) * (1.f / DM); float s2 = 0.f;
#pragma unroll
    for (int j = 0; j < 4; ++j) { v[j] = v[j] - mean; s2 += (v[j].x * v[j].x + v[j].y * v[j].y) + (v[j].z * v[j].z + v[j].w * v[j].w); }
    const float rstd = 1.f / sqrtf(wave_sum(s2) * (1.f / DM) + LN_EPS);
#pragma unroll
    for (int j = 0; j < 4; ++j) { const f32x4 gg = *((const f32x4*)g + lane + 64 * j), bb = *((const f32x4*)bta + lane + 64 * j);
        const f32x4 o = v[j] * rstd * gg + bb;
        *((f32x4*)orow + lane + 64 * j) = o;
        if (brow) { u32x2 w; w.x = pk2(o.x, o.y); w.y = pk2(o.z, o.w); *((u32x2*)brow + lane + 64 * j) = w; } }
}

template <int I> __device__ __forceinline__ float bc16(float x) {
    return __builtin_bit_cast(float, __builtin_amdgcn_update_dpp(0, __builtin_bit_cast(int, x), 0x150 + I, 0xf, 0xf, true));
}
__device__ __forceinline__ void rwkv_scan(int bh, int wv, int lane, const bf16* Zr, const bf16* LP, const bf16* KP, bf16* Y, const float* mu) {
    const int b = bh / 6, h = bh % 6, vl = lane & 15, kq = lane >> 4;
    const size_t m0 = (size_t)b * SEQ;
    const bf16* pr = Zr + m0 * ZR_P + h * 64 + lane;
    const bf16* pv = Zr + m0 * ZR_P + 768 + h * 64 + 16 * wv + vl;
    const bf16* pe = LP + m0 * LP_P + 256 + h * 64 + lane;
    const bf16* pb = LP + m0 * LP_P + 640 + h * 64 + lane;
    const bf16* pk = KP + m0 * KP_P + h * 64 + lane;
    const bf16* pn = KP + m0 * KP_P + 384 + h * 64 + lane;
    bf16* py = Y + m0 * Y_P + h * 64 + 16 * wv + vl;
    const float mur = mu[h * 64 + lane], muv = mu[768 + h * 64 + 16 * wv + vl];
    float s[16];
#pragma unroll
    for (int i = 0; i < 16; ++i) s[i] = 0.f;
    constexpr int PD = 8;
    bf16 br[PD], bv[PD], be[PD], bb[PD], bk[PD], bn[PD];
#pragma unroll
    for (int j = 0; j < PD; ++j) { br[j] = pr[(size_t)j * ZR_P]; bv[j] = pv[(size_t)j * ZR_P]; be[j] = pe[(size_t)j * LP_P]; bb[j] = pb[(size_t)j * LP_P]; bk[j] = pk[(size_t)j * KP_P]; bn[j] = pn[(size_t)j * KP_P]; }
    float rprev = 0.f, vprev = 0.f;
    for (int t0 = 0; t0 < SEQ; t0 += PD) {
#pragma unroll
        for (int j = 0; j < PD; ++j) {
            const int t = t0 + j;
            const float rr = bf2f(br[j]), vr = bf2f(bv[j]), ew = bf2f(be[j]), bvv = bf2f(bb[j]), kv = bf2f(bk[j]), av = -bf2f(bn[j]);
            { const int tn = (t + PD < SEQ) ? t + PD : SEQ - 1;
              br[j] = pr[(size_t)tn * ZR_P]; bv[j] = pv[(size_t)tn * ZR_P]; be[j] = pe[(size_t)tn * LP_P]; bb[j] = pb[(size_t)tn * LP_P]; bk[j] = pk[(size_t)tn * KP_P]; bn[j] = pn[(size_t)tn * KP_P]; }
            const float rs = rr + (rprev - rr) * mur; rprev = rr;
            const float vs = vr + (vprev - vr) * muv; vprev = vr;
            const float dec = __builtin_amdgcn_exp2f(ew * -1.44269504089f);
            float sa = 0.f;
#define SA_STEP(i) sa += s[i] * bc16<i>(av);
            SA_STEP(0) SA_STEP(1) SA_STEP(2) SA_STEP(3) SA_STEP(4) SA_STEP(5) SA_STEP(6) SA_STEP(7) SA_STEP(8) SA_STEP(9) SA_STEP(10) SA_STEP(11) SA_STEP(12) SA_STEP(13) SA_STEP(14) SA_STEP(15)
#undef SA_STEP
            sa += __shfl_xor(sa, 16); sa += __shfl_xor(sa, 32);
            float y = 0.f;
#define UP_STEP(i) { float tt = s[i] * bc16<i>(dec); tt += sa * bc16<i>(bvv); tt += vs * bc16<i>(kv); s[i] = tt; y += tt * bc16<i>(rs); }
            UP_STEP(0) UP_STEP(1) UP_STEP(2) UP_STEP(3) UP_STEP(4) UP_STEP(5) UP_STEP(6) UP_STEP(7) UP_STEP(8) UP_STEP(9) UP_STEP(10) UP_STEP(11) UP_STEP(12) UP_STEP(13) UP_STEP(14) UP_STEP(15)
#undef UP_STEP
            y += __shfl_xor(y, 16); y += __shfl_xor(y, 32);
            if (kq == 0) py[(size_t)t * Y_P] = (bf16)f2bf(y);
        }
    }
}

#define MFMA16(a, b, c) __builtin_amdgcn_mfma_f32_16x16x32_bf16(a, b, c, 0, 0, 0)
constexpr int TS = 72;
__device__ __forceinline__ void retention_item(LAS unsigned char* lds, int item, int tid, const bf16* Zt, bf16* Y, const float* gn_g, const float* gn_b,
                                               const float* ropec, const float* ropes, const float* gpow_all) {
    const int b = item / 3, hp = item % 3;
    const int hb = tid >> 8, lt = tid & 255, wv = (tid >> 6) & 3, lane = tid & 63, fr = lane & 15, fq = lane >> 4;
    const int h = hp * 2 + hb;
    LAS unsigned char* base = lds + hb * 57344;
    LAS bf16* Qs = (LAS bf16*)base; LAS bf16* Ks = (LAS bf16*)(base + 9216); LAS bf16* Kdt = (LAS bf16*)(base + 18432); LAS bf16* Vt = (LAS bf16*)(base + 27648);
    LAS bf16* Rt = (LAS bf16*)(base + 36864); LAS bf16* Ps = (LAS bf16*)(base + 46080 + wv * 2304); LAS float* gp = (LAS float*)(base + 55296);
    if (lt < 65) gp[lt] = gpow_all[h * 65 + lt];
    for (int i = lt; i < 64 * TS / 2; i += 256) ((LAS unsigned*)Rt)[i] = 0u;
    f32x4 R[4];
#pragma unroll
    for (int nt = 0; nt < 4; ++nt) R[nt] = (f32x4){0.f, 0.f, 0.f, 0.f};
    __syncthreads();
    const float cdec = gp[64];
    const int row = lt >> 2, qd = lt & 3;
    for (int n = 0; n < 32; ++n) {
        const size_t m0 = (size_t)b * SEQ + n * 64;
        {
            const bf16* zrow = Zt + (m0 + row) * ZT_P + h * 64;
            const int pos = n * 64 + row;
            float c[8], s[8];
            { const f32x4 c0 = *(const f32x4*)(ropec + pos * 32 + 8 * qd), c1 = *(const f32x4*)(ropec + pos * 32 + 8 * qd + 4);
              const f32x4 s0 = *(const f32x4*)(ropes + pos * 32 + 8 * qd), s1 = *(const f32x4*)(ropes + pos * 32 + 8 * qd + 4);
              c[0] = c0.x; c[1] = c0.y; c[2] = c0.z; c[3] = c0.w; c[4] = c1.x; c[5] = c1.y; c[6] = c1.z; c[7] = c1.w;
              s[0] = s0.x; s[1] = s0.y; s[2] = s0.z; s[3] = s0.w; s[4] = s1.x; s[5] = s1.y; s[6] = s1.z; s[7] = s1.w; }
            float a1[8], a2[8], o1[8], o2[8];
            unpack8(*(const u32x4*)(zrow + 8 * qd), a1); unpack8(*(const u32x4*)(zrow + 32 + 8 * qd), a2);
#pragma unroll
            for (int i = 0; i < 8; ++i) { o1[i] = a1[i] * c[i] - a2[i] * s[i]; o2[i] = a1[i] * s[i] + a2[i] * c[i]; }
            *(LAS u32x4*)(Qs + row * TS + 8 * qd) = pack8(o1); *(LAS u32x4*)(Qs + row * TS + 32 + 8 * qd) = pack8(o2);
            unpack8(*(const u32x4*)(zrow + 384 + 8 * qd), a1); unpack8(*(const u32x4*)(zrow + 384 + 32 + 8 * qd), a2);
#pragma unroll
            for (int i = 0; i < 8; ++i) { o1[i] = (a1[i] * c[i] - a2[i] * s[i]) * 0.125f; o2[i] = (a1[i] * s[i] + a2[i] * c[i]) * 0.125f; }
            *(LAS u32x4*)(Ks + row * TS + 8 * qd) = pack8(o1); *(LAS u32x4*)(Ks + row * TS + 32 + 8 * qd) = pack8(o2);
            const float kd = gp[63 - row];
#pragma unroll
            for (int i = 0; i < 8; ++i) { Kdt[(8 * qd + i) * TS + row] = (bf16)f2bf(o1[i] * kd); Kdt[(32 + 8 * qd + i) * TS + row] = (bf16)f2bf(o2[i] * kd); }
            const u32x4 v0 = *(const u32x4*)(zrow + 768 + 16 * qd), v1 = *(const u32x4*)(zrow + 768 + 16 * qd + 8);
            const unsigned vw[8] = {v0.x, v0.y, v0.z, v0.w, v1.x, v1.y, v1.z, v1.w};
#pragma unroll
            for (int i = 0; i < 8; ++i) { Vt[(16 * qd + 2 * i) * TS + row] = (bf16)(vw[i] & 0xffffu); Vt[(16 * qd + 2 * i + 1) * TS + row] = (bf16)(vw[i] >> 16); }
        }
        __syncthreads();
        f32x4 y[4];
        {
            bf16x8 aq[2];
#pragma unroll
            for (int ks = 0; ks < 2; ++ks) aq[ks] = *(const LAS bf16x8*)(Qs + (16 * wv + fr) * TS + 32 * ks + 8 * fq);
#pragma unroll
            for (int nt = 0; nt < 4; ++nt) { f32x4 acc = (f32x4){0.f, 0.f, 0.f, 0.f};
#pragma unroll
                for (int ks = 0; ks < 2; ++ks) acc = MFMA16(aq[ks], *(const LAS bf16x8*)(Rt + (16 * nt + fr) * TS + 32 * ks + 8 * fq), acc);
#pragma unroll
                for (int j = 0; j < 4; ++j) acc[j] *= gp[16 * wv + 4 * fq + j + 1];
                y[nt] = acc; }
#pragma unroll
            for (int nt = 0; nt < 4; ++nt) { f32x4 acc = (f32x4){0.f, 0.f, 0.f, 0.f};
#pragma unroll
                for (int ks = 0; ks < 2; ++ks) acc = MFMA16(aq[ks], *(const LAS bf16x8*)(Ks + (16 * nt + fr) * TS + 32 * ks + 8 * fq), acc);
#pragma unroll
                for (int j = 0; j < 4; ++j) { const int i = 16 * wv + 4 * fq + j, jj = 16 * nt + fr; const int d = i > jj ? i - jj : jj - i;
                    Ps[(4 * fq + j) * TS + 16 * nt + fr] = (bf16)f2bf(acc[j] * gp[d]); } }
            LDS_WAIT();
            bf16x8 ap[2];
#pragma unroll
            for (int ks = 0; ks < 2; ++ks) ap[ks] = *(const LAS bf16x8*)(Ps + fr * TS + 32 * ks + 8 * fq);
            bf16x8 ak[2];
#pragma unroll
            for (int ks = 0; ks < 2; ++ks) ak[ks] = *(const LAS bf16x8*)(Kdt + (16 * wv + fr) * TS + 32 * ks + 8 * fq);
#pragma unroll
            for (int nt = 0; nt < 4; ++nt) { f32x4 rn = R[nt] * cdec;
#pragma unroll
                for (int ks = 0; ks < 2; ++ks) { const bf16x8 vb = *(const LAS bf16x8*)(Vt + (16 * nt + fr) * TS + 32 * ks + 8 * fq);
                    y[nt] = MFMA16(ap[ks], vb, y[nt]); rn = MFMA16(ak[ks], vb, rn); }
                R[nt] = rn; }
        }
        __syncthreads();
#pragma unroll
        for (int nt = 0; nt < 4; ++nt) { u32x2 w; w.x = pk2(R[nt][0], R[nt][1]); w.y = pk2(R[nt][2], R[nt][3]); *(LAS u32x2*)(Rt + (16 * nt + fr) * TS + 16 * wv + 4 * fq) = w; }
        float gg[4], gb[4];
#pragma unroll
        for (int nt = 0; nt < 4; ++nt) { gg[nt] = gn_g[h * 64 + 16 * nt + fr]; gb[nt] = gn_b[h * 64 + 16 * nt + fr]; }
#pragma unroll
        for (int j = 0; j < 4; ++j) {
            const float mean = row16_sum((y[0][j] + y[1][j]) + (y[2][j] + y[3][j])) * (1.f / 64.f);
            float q = 0.f;
#pragma unroll
            for (int nt = 0; nt < 4; ++nt) { const float d = y[nt][j] - mean; q += d * d; }
            const float rstd = 1.f / sqrtf(row16_sum(q) * (1.f / 64.f) + 1e-5f);
            const size_t m = m0 + 16 * wv + 4 * fq + j;
#pragma unroll
            for (int nt = 0; nt < 4; ++nt) { const int e = 16 * nt + fr;
                const float g = bf2f(Zt[m * ZT_P + 1152 + h * 64 + e]);
                const float o = ((y[nt][j] - mean) * rstd * gg[nt] + gb[nt]) * (g * sigmoidf_(g));
                Y[m * Y_P + 384 + h * 64 + e] = (bf16)f2bf(o); }
        }
    }
    __syncthreads();
}

__device__ __forceinline__ void attention_item(LAS unsigned char* lds, int item, int tid, const bf16* Za, bf16* Y, const float* rel_bias) {
    const int n = 31 - item / 64, rest = item % 64, b = rest >> 1, hp = rest & 1;
    const int hb = tid >> 8, lt = tid & 255, wv = (tid >> 6) & 3, lane = tid & 63, fr = lane & 15, fq = lane >> 4;
    const int h = hp * 2 + hb;
    LAS unsigned char* base = lds + hb * 40960;
    LAS bf16* Qs = (LAS bf16*)base; LAS bf16* Ks = (LAS bf16*)(base + 9216); LAS bf16* Vt = (LAS bf16*)(base + 18432);
    LAS bf16* Ps = (LAS bf16*)(base + 27648 + wv * 2304); LAS float* bt = (LAS float*)(base + 36864);
    const int row = lt >> 2, qd = lt & 3;
    if (lt < 192) bt[lt] = rel_bias[h * 192 + lt];
    { const bf16* qrow = Za + ((size_t)b * SEQ + n * 64 + row) * ZA_P + h * 64 + 16 * qd;
      *(LAS u32x4*)(Qs + row * TS + 16 * qd) = *(const u32x4*)qrow; *(LAS u32x4*)(Qs + row * TS + 16 * qd + 8) = *(const u32x4*)(qrow + 8); }
    float mrun[4], lrun[4]; f32x4 O[4];
#pragma unroll
    for (int j = 0; j < 4; ++j) { mrun[j] = -1e30f; lrun[j] = 0.f; }
#pragma unroll
    for (int nt = 0; nt < 4; ++nt) O[nt] = (f32x4){0.f, 0.f, 0.f, 0.f};
    const int kc0 = n > 8 ? n - 8 : 0;
    for (int kc = kc0; kc <= n; ++kc) {
        __syncthreads();
        { const bf16* krow = Za + ((size_t)b * SEQ + kc * 64 + row) * ZA_P + 256 + h * 64 + 16 * qd;
          *(LAS u32x4*)(Ks + row * TS + 16 * qd) = *(const u32x4*)krow; *(LAS u32x4*)(Ks + row * TS + 16 * qd + 8) = *(const u32x4*)(krow + 8);
          const u32x4 v0 = *(const u32x4*)(krow + 256), v1 = *(const u32x4*)(krow + 256 + 8);
          const unsigned vw[8] = {v0.x, v0.y, v0.z, v0.w, v1.x, v1.y, v1.z, v1.w};
#pragma unroll
          for (int i = 0; i < 8; ++i) { Vt[(16 * qd + 2 * i) * TS + row] = (bf16)(vw[i] & 0xffffu); Vt[(16 * qd + 2 * i + 1) * TS + row] = (bf16)(vw[i] >> 16); } }
        __syncthreads();
        bf16x8 aq[2];
#pragma unroll
        for (int ks = 0; ks < 2; ++ks) aq[ks] = *(const LAS bf16x8*)(Qs + (16 * wv + fr) * TS + 32 * ks + 8 * fq);
        f32x4 sc[4];
#pragma unroll
        for (int nt = 0; nt < 4; ++nt) { f32x4 acc = (f32x4){0.f, 0.f, 0.f, 0.f};
#pragma unroll
            for (int ks = 0; ks < 2; ++ks) acc = MFMA16(aq[ks], *(const LAS bf16x8*)(Ks + (16 * nt + fr) * TS + 32 * ks + 8 * fq), acc);
#pragma unroll
            for (int j = 0; j < 4; ++j) { int rel = 64 * (n - kc) + (16 * wv + 4 * fq + j) - (16 * nt + fr); rel = rel < -63 ? -63 : (rel > 128 ? 128 : rel); acc[j] += bt[rel + 63]; }
            sc[nt] = acc; }
#pragma unroll
        for (int j = 0; j < 4; ++j) {
            const float mx = row16_max(fmaxf(fmaxf(sc[0][j], sc[1][j]), fmaxf(sc[2][j], sc[3][j])));
            const float mnew = fmaxf(mrun[j], mx), corr = __expf(mrun[j] - mnew);
            float ps = 0.f;
#pragma unroll
            for (int nt = 0; nt < 4; ++nt) { const float p = __expf(sc[nt][j] - mnew); ps += p; Ps[(4 * fq + j) * TS + 16 * nt + fr] = (bf16)f2bf(p); O[nt][j] *= corr; }
            lrun[j] = lrun[j] * corr + row16_sum(ps); mrun[j] = mnew;
        }
        LDS_WAIT();
        bf16x8 ap[2];
#pragma unroll
        for (int ks = 0; ks < 2; ++ks) ap[ks] = *(const LAS bf16x8*)(Ps + fr * TS + 32 * ks + 8 * fq);
#pragma unroll
        for (int nt = 0; nt < 4; ++nt)
#pragma unroll
            for (int ks = 0; ks < 2; ++ks) O[nt] = MFMA16(ap[ks], *(const LAS bf16x8*)(Vt + (16 * nt + fr) * TS + 32 * ks + 8 * fq), O[nt]);
    }
#pragma unroll
    for (int j = 0; j < 4; ++j) { const float inv = 1.f / lrun[j]; const size_t m = (size_t)b * SEQ + n * 64 + 16 * wv + 4 * fq + j;
#pragma unroll
        for (int nt = 0; nt < 4; ++nt) Y[m * Y_P + 768 + h * 64 + 16 * nt + fr] = (bf16)f2bf(O[nt][j] * inv); }
    __syncthreads();
}

struct Args { const float* in[27]; float* out; unsigned char* ws; };
constexpr int N_RET_ITEMS = 96, N_ATT_ITEMS = 2048, N_SCAN_BLOCKS = 192;

#define KARG(off) (*(const float* const __attribute__((address_space(4)))*)(kp + (off)))
#define PHASE_LOCALS \
    int tid = threadIdx.x; asm volatile("" : "+v"(tid)); \
    const int lane = tid & 63, wave = __builtin_amdgcn_readfirstlane(tid >> 6); \
    const __attribute__((address_space(4))) unsigned char* kp = (const __attribute__((address_space(4))) unsigned char*)__builtin_amdgcn_kernarg_segment_ptr(); asm volatile("" : "+s"(kp)); \
    unsigned char* ws = (unsigned char*)KARG(224); \
    const int G = gridDim.x, bx = blockIdx.x; \
    const int gw = bx * 8 + wave, NGW = G * 8, gt = bx * 512 + tid, NGT = G * 512; \
    (void)lane; (void)gw; (void)NGW; (void)gt; (void)NGT; (void)ws;
#define IN(i) KARG(8 * (i))
#define XPTR ((float*)KARG(216))

__global__ void __launch_bounds__(512, 2) fwd_megakernel(Args a) {
    extern __shared__ __attribute__((aligned(16))) unsigned char lds_raw[];
    LAS unsigned char* lds = (LAS unsigned char*)lds_raw;
    cg::grid_group grid = cg::this_grid();

    {
        PHASE_LOCALS
        unsigned* ctl = (unsigned*)(ws + WS_CTL);
        float* ropec = (float*)(ws + WS_ROPEC); float* ropes = (float*)(ws + WS_ROPES); float* gpow = (float*)(ws + WS_GPOW);
        if (bx == 0 && tid < 16) ctl[tid] = 0u;
        LAS float* scr = (LAS float*)(lds + wave * 16384);
        constexpr int I_IN = 16 * (NIN / 32), I_OUT = 16 * 32, I_UP = 16 * (DFF2 / 32), I_DN = (DFF / 64) * 32, I_L = I_IN + I_OUT + I_UP + I_DN;
        for (int it = gw; it < 2 * I_L; it += NGW) {
            const int l = it / I_L; int r = it % I_L;
            unsigned char* wl = ws + WS_W + (size_t)l * W_LAYER;
            if (r < I_IN) { p0_transpose_item(IN(3) + (size_t)l * DM * NIN, DM, NIN, (bf16*)(wl + WO_IN), 1, scr, r, lane); continue; } r -= I_IN;
            if (r < I_OUT) { p0_transpose_item(IN(18) + (size_t)l * DM * DM, DM, DM, (bf16*)(wl + WO_OUT), 0, scr, r, lane); continue; } r -= I_OUT;
            if (r < I_UP) { p0_transpose_item(IN(21) + (size_t)l * DM * DFF2, DM, DFF2, (bf16*)(wl + WO_UP), 2, scr, r, lane); continue; } r -= I_UP;
            p0_transpose_item(IN(24) + (size_t)l * DFF * DM, DFF, DM, (bf16*)(wl + WO_DN), 0, scr, r, lane);
        }
        for (int i = gt; i < 2 * 128 * DM / 8; i += NGT) {
            const int l = i / (128 * DM / 8), r = i % (128 * DM / 8);
            *((u32x4*)(ws + WS_W + (size_t)l * W_LAYER + WO_IN + (size_t)1408 * DM * 2) + r) = (u32x4){0u, 0u, 0u, 0u};
        }
        for (int i = gt; i < 2 * NLORA * KLORA; i += NGT) {
            const int l = i / (NLORA * KLORA), r = i % (NLORA * KLORA), n = r / KLORA, k = r % KLORA;
            float v = 0.f;
            if (n < 384) { if (k < 64) v = IN(6)[(size_t)l * 64 * 384 + k * 384 + n]; }
            else if (n < 768) { if (k >= 64 && k < 128) v = IN(8)[(size_t)l * 64 * 384 + (k - 64) * 384 + (n - 384)]; }
            else if (n < 1152) { if (k >= 128) v = IN(9)[(size_t)l * 128 * 384 + (k - 128) * 384 + (n - 768)]; }
            ((bf16*)(ws + WS_W + (size_t)l * W_LAYER + WO_LORA))[r] = (bf16)f2bf(v);
        }
        for (int i = gt; i < SEQ * 32; i += NGT) {
            const int t = i >> 5, ii = i & 31;
            const float inv = (float)exp2(-(double)ii * (13.287712379549449 / 32.0));
            const float ang = (float)t * inv;
            const double rev = (double)ang * 0.15915494309189535; const float fr_ = (float)(rev - floor(rev));
            ropec[i] = __builtin_amdgcn_cosf(fr_); ropes[i] = __builtin_amdgcn_sinf(fr_);
        }
        if (gt < 6) { const double g = 1.0 - exp2(-5.0 - (double)gt); double p = 1.0; for (int nn = 0; nn <= 64; ++nn) { gpow[gt * 65 + nn] = (float)p; p *= g; } }
        float* X = XPTR; bf16* XN = (bf16*)(ws + WS_XN);
        for (int m = gw; m < MTOK; m += NGW) ln_row(IN(0) + (size_t)m * DM, IN(1), IN(2), X + (size_t)m * DM, XN + (size_t)m * DM, lane);
    }
    grid.sync();

    for (int l = 0; l < 2; ++l) {
        { PHASE_LOCALS
          pg8::Gemm g{(const bf16*)(ws + WS_XN), (const bf16*)(ws + WS_W + (size_t)l * W_LAYER + WO_IN), MTOK, NIN_PAD, DM, DM}; pg8::StaticOrder S; S.init(MTOK, NIN_PAD, G, bx);
          pg8::EpiZ E{(bf16*)(ws + WS_ZR), (bf16*)(ws + WS_ZT), (bf16*)(ws + WS_ZA)}; pg8::gemm_phase<pg8::EpiZ>(lds, g, S, E); }
        grid.sync();
        { PHASE_LOCALS
          const bf16* Zr = (const bf16*)(ws + WS_ZR); bf16* LP = (bf16*)(ws + WS_LP); const float* mu = IN(4) + l * 1408;
          for (int i = gt; i < MTOK * 32; i += NGT) {
            const int m = i >> 5, c8 = i & 31;
            float cur[8], prv[8], o[8];
            unpack8(*(const u32x4*)(Zr + (size_t)m * ZR_P + 1152 + 8 * c8), cur);
            if ((m & (SEQ - 1)) != 0) unpack8(*(const u32x4*)(Zr + (size_t)(m - 1) * ZR_P + 1152 + 8 * c8), prv);
            else {
#pragma unroll
                for (int j = 0; j < 8; ++j) prv[j] = 0.f; }
#pragma unroll
            for (int j = 0; j < 8; ++j) { const float sft = cur[j] + (prv[j] - cur[j]) * mu[1152 + 8 * c8 + j];
                o[j] = c8 < 8 ? (1.f - 2.f / (__expf(2.f * sft) + 1.f)) : (c8 < 16 ? sft : sigmoidf_(sft)); }
            *(u32x4*)(LP + (size_t)m * LP_P + 8 * c8) = pack8(o);
          } }
        grid.sync();
        { PHASE_LOCALS
          bf16* LP = (bf16*)(ws + WS_LP);
          pg8::Gemm g{LP, (const bf16*)(ws + WS_W + (size_t)l * W_LAYER + WO_LORA), MTOK, NLORA, KLORA, LP_P}; pg8::StaticOrder S; S.init(MTOK, NLORA, G, bx);
          pg8::EpiBf16 E{LP + 256, LP_P}; pg8::gemm_phase<pg8::EpiBf16>(lds, g, S, E); }
        grid.sync();
        { PHASE_LOCALS
            const bf16* Zr = (const bf16*)(ws + WS_ZR); bf16* LP = (bf16*)(ws + WS_LP); bf16* KP = (bf16*)(ws + WS_XN); float* BONUS = (float*)(ws + WS_BONUS);
            const float* mu = IN(4) + l * 1408;
            const float* w0 = IN(5) + l * 384; const float* a0 = IN(7) + l * 384; const float* k_k = IN(10) + l * 384; const float* k_a = IN(11) + l * 384; const float* r_k = IN(12) + l * 384;
            for (int m = gw; m < MTOK; m += NGW) {
                const bool hasprev = (m & (SEQ - 1)) != 0;
                const bf16* z = Zr + (size_t)m * ZR_P; const bf16* zp = z - ZR_P;
                bf16* lp = LP + (size_t)m * LP_P; bf16* kpp = KP + (size_t)m * KP_P;
#pragma unroll
                for (int h = 0; h < 6; ++h) {
                    const int c = h * 64 + lane;
                    const float k = bf2f(z[384 + c]), r = bf2f(z[c]);
                    const float kprev = hasprev ? bf2f(zp[384 + c]) : 0.f, rprev = hasprev ? bf2f(zp[c]) : 0.f;
                    const float wpre = bf2f(lp[256 + c]), apre = bf2f(lp[640 + c]);
                    const float ks = k + (kprev - k) * mu[384 + c], rs = r + (rprev - r) * mu[c];
                    const float av = sigmoidf_(a0[c] + apre);
                    const float xx = -(w0[c] + wpre);
                    const float sp = fmaxf(xx, 0.f) + __logf(1.f + __expf(-fabsf(xx)));
                    const float ew = __expf(-sp - 0.5f);
                    const float kk = ks * k_k[c];
                    const float n2 = wave_sum(kk * kk);
                    const float kkn = kk / fmaxf(sqrtf(n2), 1e-12f);
                    const float kpr = ks * (1.f + (av - 1.f) * k_a[c]);
                    const float bon = wave_sum(rs * kpr * r_k[c]);
                    lp[256 + c] = (bf16)f2bf(ew); lp[640 + c] = (bf16)f2bf(kkn * av);
                    kpp[c] = (bf16)f2bf(kpr); kpp[384 + c] = (bf16)f2bf(kkn);
                    if (lane == 0) BONUS[(size_t)m * 6 + h] = bon;
                }
            }
        }
        grid.sync();
        { PHASE_LOCALS
            bf16* Yb = (bf16*)(ws + WS_Y);
            volatile LAS int* sh_item = (volatile LAS int*)(lds + MISC_OFF);
            if (bx < N_SCAN_BLOCKS && wave < 4) rwkv_scan(bx, wave, lane, (const bf16*)(ws + WS_ZR), (const bf16*)(ws + WS_LP), (const bf16*)(ws + WS_XN), Yb, IN(4) + l * 1408);
            __syncthreads();
            for (;;) {
                if (tid == 0) *sh_item = (int)atomicAdd((unsigned*)(ws + WS_CTL) + l, 1u);
                __syncthreads();
                const int item = *sh_item;
                __syncthreads();
                if (item >= N_RET_ITEMS + N_ATT_ITEMS) break;
                if (item < N_RET_ITEMS) retention_item(lds, item, tid, (const bf16*)(ws + WS_ZT), Yb, IN(15) + l * 384, IN(16) + l * 384, (const float*)(ws + WS_ROPEC), (const float*)(ws + WS_ROPES), (const float*)(ws + WS_GPOW));
                else attention_item(lds, item - N_RET_ITEMS, tid, (const bf16*)(ws + WS_ZA), Yb, IN(17) + l * 4 * 192);
            }
        }
        grid.sync();
        { PHASE_LOCALS
            const bf16* Zr = (const bf16*)(ws + WS_ZR); const bf16* LP = (const bf16*)(ws + WS_LP); bf16* Yb = (bf16*)(ws + WS_Y); const float* BONUS = (const float*)(ws + WS_BONUS);
            const float* mu = IN(4) + l * 1408;
            const float* lng = IN(13) + l * 384; const float* lnb = IN(14) + l * 384;
            for (int m = gw; m < MTOK; m += NGW) {
                const bool hasprev = (m & (SEQ - 1)) != 0;
                const bf16* z = Zr + (size_t)m * ZR_P; const bf16* zp = z - ZR_P;
                const bf16* lp = LP + (size_t)m * LP_P; bf16* yr = Yb + (size_t)m * Y_P;
#pragma unroll
                for (int h = 0; h < 6; ++h) {
                    const int c = h * 64 + lane;
                    const float yv = bf2f(yr[c]);
                    const float v = bf2f(z[768 + c]), vprev = hasprev ? bf2f(zp[768 + c]) : 0.f;
                    const float vs = v + (vprev - v) * mu[768 + c];
                    const float gte = bf2f(lp[1024 + c]);
                    const float bon = BONUS[(size_t)m * 6 + h];
                    const float mean = wave_sum(yv) * (1.f / 64.f);
                    const float d = yv - mean;
                    const float var = wave_sum(d * d) * (1.f / 64.f);
                    const float o = (d * (1.f / sqrtf(var + 64e-5f)) * lng[c] + lnb[c] + bon * vs) * gte;
                    yr[c] = (bf16)f2bf(o);
                }
            }
        }
        grid.sync();
        { PHASE_LOCALS
          pg8::Gemm g{(const bf16*)(ws + WS_Y), (const bf16*)(ws + WS_W + (size_t)l * W_LAYER + WO_OUT), MTOK, DM, DM, DM}; pg8::StaticOrder S; S.init(MTOK, DM, G, bx);
          pg8::EpiRes E{XPTR, ALPHA}; pg8::gemm_phase<pg8::EpiRes>(lds, g, S, E); }
        grid.sync();
        { PHASE_LOCALS
          float* X = XPTR; bf16* XN = (bf16*)(ws + WS_XN);
          for (int m = gw; m < MTOK; m += NGW) ln_row(X + (size_t)m * DM, IN(19) + l * DM, IN(20) + l * DM, X + (size_t)m * DM, XN + (size_t)m * DM, lane); }
        grid.sync();
        for (int half = 0; half < 2; ++half) {
            { PHASE_LOCALS
              const size_t moff = (size_t)half * MHALF;
              pg8::Gemm g{(const bf16*)(ws + WS_XN) + moff * DM, (const bf16*)(ws + WS_W + (size_t)l * W_LAYER + WO_UP), MHALF, DFF2, DM, DM}; pg8::StaticOrder S; S.init(MHALF, DFF2, G, bx);
              pg8::EpiBf16 E{(bf16*)(ws + WS_U), DFF2}; pg8::gemm_phase<pg8::EpiBf16>(lds, g, S, E); }
            grid.sync();
            { PHASE_LOCALS
                const bf16* U = (const bf16*)(ws + WS_U); bf16* HH = (bf16*)(ws + WS_HH);
                const float* cw = IN(22) + (size_t)l * 3 * DFF2; const float* cb = IN(23) + (size_t)l * DFF2;
                if (tid < 352) {
                    const int j0 = 8 * tid, pn = j0 >> 7, i0 = j0 & 127, cg_ = 256 * pn + i0, cv_ = cg_ + 128;
                    float wg[3][8], wv_[3][8], bg[8], bv_[8];
#pragma unroll
                    for (int j = 0; j < 8; ++j) { bg[j] = cb[j0 + j]; bv_[j] = cb[DFF + j0 + j];
#pragma unroll
                        for (int t = 0; t < 3; ++t) { wg[t][j] = cw[t * DFF2 + j0 + j]; wv_[t][j] = cw[t * DFF2 + DFF + j0 + j]; } }
                    for (int run = bx; run < MHALF / 64; run += G) {
                        const int r0 = run * 64;
                        float g1[8], g2[8], v1[8], v2[8];
                        if ((r0 & (SEQ - 1)) != 0) {
                            unpack8(*(const u32x4*)(U + (size_t)(r0 - 1) * DFF2 + cg_), g1); unpack8(*(const u32x4*)(U + (size_t)(r0 - 2) * DFF2 + cg_), g2);
                            unpack8(*(const u32x4*)(U + (size_t)(r0 - 1) * DFF2 + cv_), v1); unpack8(*(const u32x4*)(U + (size_t)(r0 - 2) * DFF2 + cv_), v2);
                        } else {
#pragma unroll
                            for (int j = 0; j < 8; ++j) { g1[j] = g2[j] = v1[j] = v2[j] = 0.f; } }
#pragma unroll 2
                        for (int rr = 0; rr < 64; ++rr) {
                            float g0[8], v0[8], o[8];
                            unpack8(*(const u32x4*)(U + (size_t)(r0 + rr) * DFF2 + cg_), g0); unpack8(*(const u32x4*)(U + (size_t)(r0 + rr) * DFF2 + cv_), v0);
#pragma unroll
                            for (int j = 0; j < 8; ++j) {
                                const float cgate = bg[j] + wg[0][j] * g2[j] + wg[1][j] * g1[j] + wg[2][j] * g0[j];
                                const float cval = bv_[j] + wv_[0][j] * v2[j] + wv_[1][j] * v1[j] + wv_[2][j] * v0[j];
                                o[j] = cgate * sigmoidf_(cgate) * cval;
                                g2[j] = g1[j]; g1[j] = g0[j]; v2[j] = v1[j]; v1[j] = v0[j];
                            }
                            *(u32x4*)(HH + (size_t)(r0 + rr) * DFF + j0) = pack8(o);
                        }
                    }
                }
            }
            grid.sync();
            { PHASE_LOCALS
              const size_t moff = (size_t)half * MHALF;
              pg8::Gemm g{(const bf16*)(ws + WS_HH), (const bf16*)(ws + WS_W + (size_t)l * W_LAYER + WO_DN), MHALF, DM, DFF, DFF}; pg8::StaticOrder S; S.init(MHALF, DM, G, bx);
              pg8::EpiRes E{XPTR + moff * DM, ALPHA}; pg8::gemm_phase<pg8::EpiRes>(lds, g, S, E); }
            grid.sync();
        }
        { PHASE_LOCALS
          float* X = XPTR; bf16* XN = (bf16*)(ws + WS_XN);
          for (int m = gw; m < MTOK; m += NGW) ln_row(X + (size_t)m * DM, IN(25) + l * DM, IN(26) + l * DM, X + (size_t)m * DM, (l == 0) ? XN + (size_t)m * DM : (bf16*)nullptr, lane); }
        if (l == 0) grid.sync();
    }
}

extern "C" void kernel_launch(void* const* d_in, const int* in_sizes, int n_in, void* d_out, int out_size, void* d_ws, size_t ws_size, hipStream_t stream) {
    static int grid = 0;
    if (grid == 0) {
        if (n_in != 27 || out_size != MTOK * DM || ws_size < WS_END) { fprintf(stderr, "kernel_launch: unexpected shapes (n_in %d out %d ws %zu)\n", n_in, out_size, ws_size); grid = -1; return; }
        int dev = 0, cus = 0, per_cu = 0;
        hipGetDevice(&dev); hipDeviceGetAttribute(&cus, hipDeviceAttributeMultiprocessorCount, dev);
        if (hipFuncSetAttribute((const void*)fwd_megakernel, hipFuncAttributeMaxDynamicSharedMemorySize, LDS_BYTES) != hipSuccess) { fprintf(stderr, "kernel_launch: hipFuncSetAttribute failed\n"); grid = -1; return; }
        if (hipOccupancyMaxActiveBlocksPerMultiprocessor(&per_cu, (const void*)fwd_megakernel, 512, LDS_BYTES) != hipSuccess || per_cu < 1) { fprintf(stderr, "kernel_launch: occupancy query says %d\n", per_cu); per_cu = 1; }
        (void)hipGetLastError();
        grid = cus;
        if (grid > 256) grid = 256;
    }
    if (grid < 0) return;
    Args a{};
    for (int i = 0; i < 27; ++i) a.in[i] = (const float*)d_in[i];
    a.out = (float*)d_out; a.ws = (unsigned char*)d_ws;
    void* args[] = {&a};
    hipError_t e = hipLaunchCooperativeKernel((const void*)fwd_megakernel, dim3(grid), dim3(512), args, LDS_BYTES, stream);
    if (e != hipSuccess) fprintf(stderr, "cooperative launch failed: %s (grid %d)\n", hipGetErrorString(e), grid);
}
```

```cpp
#include <hip/hip_runtime.h>
#include <hip/hip_cooperative_groups.h>
#include <cstdio>
#include <cstdint>
namespace cg = cooperative_groups;

#define LAS __attribute__((address_space(3)))
typedef unsigned short bf16;
typedef short bf16x8 __attribute__((ext_vector_type(8)));
typedef float f32x4 __attribute__((ext_vector_type(4)));
typedef float f32x2 __attribute__((ext_vector_type(2)));
typedef unsigned u32x4 __attribute__((ext_vector_type(4)));
typedef unsigned u32x2 __attribute__((ext_vector_type(2)));

constexpr int NB = 32, SEQ = 2048, DM = 1024, MTOK = NB * SEQ;
constexpr int ZR_P = 1536, ZT_P = 1536, ZA_P = 768, LP_P = 1536, Y_P = 1024, KP_P = 1024;
constexpr int NIN = 3712, NIN_PAD = 3840, DFF = 2816, DFF2 = 5632, NLORA = 1280, KLORA = 256;
constexpr int MHALF = MTOK / 2;
constexpr float ALPHA = 1.41421356237309515f;
constexpr float LN_EPS = 1e-5f;

constexpr size_t MiB = 1u << 20;
constexpr size_t WS_CTL = 0;
constexpr size_t WS_ROPEC = 1 * MiB, WS_ROPES = WS_ROPEC + 256 * 1024, WS_GPOW = WS_ROPES + 256 * 1024;
constexpr size_t WS_W = 2 * MiB, W_LAYER = 27 * MiB;
constexpr size_t WO_IN = 0, WO_OUT = WO_IN + (size_t)NIN_PAD * DM * 2, WO_UP = WO_OUT + (size_t)DM * DM * 2,
                 WO_DN = WO_UP + (size_t)DFF2 * DM * 2, WO_LORA = WO_DN + (size_t)DM * DFF * 2, WO_END = WO_LORA + (size_t)NLORA * KLORA * 2;
static_assert(WO_END <= W_LAYER, "weights per layer");
constexpr size_t WS_XN = 64 * MiB, WS_Y = 192 * MiB, WS_ZR = 320 * MiB, WS_ZT = 512 * MiB, WS_ZA = 704 * MiB, WS_LP = 800 * MiB, WS_BONUS = 992 * MiB;
constexpr size_t WS_HH = 320 * MiB, WS_UB = 672 * MiB, WS_END = 1024 * MiB;
static_assert(WS_HH + (size_t)MTOK * DFF * 2 <= WS_UB && WS_UB + (size_t)(MTOK / 64) * 4 * DFF2 * 2 <= WS_END, "ffn map");

constexpr int LDS_BYTES = 147456;
constexpr int MISC_OFF = 131072;

#define KARG(off) (*(const float* const __attribute__((address_space(4)))*)(kp + (off)))
template <int N> __device__ __forceinline__ float dpp_ror(float x) { return __builtin_bit_cast(float, __builtin_amdgcn_update_dpp(0, __builtin_bit_cast(int, x), 0x120 + N, 0xf, 0xf, true)); }
namespace pg8 {
constexpr int BM = 256, BK = 64, HALF = 128, HTB = HALF * BK * 2, NXCD = 8, WGM = 8;
__host__ __device__ __forceinline__ int lds_byte(int r, int c) { const int st = (r >> 4) * 2 + (c >> 5), rr = r & 15, cc = c & 31, ob = rr * 64 + cc * 2; return st * 1024 + (ob ^ (((ob >> 9) & 1) << 5)); }
__host__ __device__ __forceinline__ void stage_rc(int b, int& R, int& C) { const int st = b / 1024, sb = b % 1024, swz = sb ^ (((sb >> 9) & 1) << 5); R = (st >> 1) * 16 + swz / 64; C = (st & 1) * 32 + (swz % 64) / 2; }
__host__ __device__ __forceinline__ int perm32(int rho) { const int n = rho >> 4, i = rho & 15; return 8 * (i >> 2) + 4 * n + (i & 3); }
struct Unit { int pm, pn; };
struct Gemm { const bf16* A; const bf16* Bt; int M, N, K, lda; };
struct StaticOrder {
    int nM, nN, nwg, G, c, i0, ni;
    __device__ void init(int M, int N, int G_, int c_) { nM = M / BM; nN = N / BM; nwg = nM * nN; G = G_; c = c_; i0 = 0; ni = 1 << 30; }
    __device__ bool next(int i, Unit& u) const {
        if (i >= ni) return false;
        const long L = (long)(i + i0) * G + c; if (L >= nwg) return false;
        int wgid = (int)L; { const int q = nwg / NXCD, r = nwg % NXCD, xcd = wgid % NXCD, off = wgid / NXCD; wgid = (xcd < r ? xcd * (q + 1) : r * (q + 1) + (xcd - r) * q) + off; }
        const int nig = WGM * nN, gid = wgid / nig, fm = gid * WGM, gsz = (nM - fm) < WGM ? (nM - fm) : WGM;
        u.pm = fm + ((wgid % nig) % gsz); u.pn = (wgid % nig) / gsz; return true;
    }
};
__device__ __forceinline__ unsigned cvt_pk_bf16(float lo, float hi) { unsigned r; asm volatile("v_cvt_pk_bf16_f32 %0, %1, %2" : "=v"(r) : "v"(lo), "v"(hi)); return r; }

struct EpiBf16 {
    static constexpr bool PERM = true, STAGED = false, AFTER_DRAIN = false;
    bf16* O; int ldc;
    __device__ __forceinline__ void operator()(const f32x4 (&acc)[2][2][4][2], const Unit& u, int wr, int wc, int fr, int fq) const {
        const int row0 = u.pm * BM + wr * 64 + fr, col0 = u.pn * BM + wc * 32 + 8 * fq;
#pragma unroll
        for (int ai = 0; ai < 2; ++ai)
#pragma unroll
            for (int m = 0; m < 4; ++m) { bf16* rowp = O + (size_t)(row0 + ai * HALF + m * 16) * ldc + col0;
#pragma unroll
                for (int bj = 0; bj < 2; ++bj) { const f32x4 v0 = acc[ai][bj][m][0], v1 = acc[ai][bj][m][1];
                    u32x4 w; w.x = cvt_pk_bf16(v0[0], v0[1]); w.y = cvt_pk_bf16(v0[2], v0[3]); w.z = cvt_pk_bf16(v1[0], v1[1]); w.w = cvt_pk_bf16(v1[2], v1[3]);
                    *(u32x4*)(rowp + bj * HALF) = w; } }
    }
};
struct EpiZ {
    static constexpr bool PERM = true, STAGED = false, AFTER_DRAIN = false;
    bf16 *Zr, *Zt, *Za;
    __device__ __forceinline__ void operator()(const f32x4 (&acc)[2][2][4][2], const Unit& u, int wr, int wc, int fr, int fq) const {
        bf16* base; int ldc, colt; float sc = 1.f;
        if (u.pn < 6) { base = Zr; ldc = ZR_P; colt = u.pn * BM; } else if (u.pn < 12) { base = Zt; ldc = ZT_P; colt = (u.pn - 6) * BM; } else { base = Za; ldc = ZA_P; colt = (u.pn - 12) * BM; if (u.pn == 12) sc = 0.125f; }
        const int row0 = u.pm * BM + wr * 64 + fr, col0 = colt + wc * 32 + 8 * fq;
#pragma unroll
        for (int ai = 0; ai < 2; ++ai)
#pragma unroll
            for (int m = 0; m < 4; ++m) { bf16* rowp = base + (size_t)(row0 + ai * HALF + m * 16) * ldc + col0;
#pragma unroll
                for (int bj = 0; bj < 2; ++bj) { const f32x4 v0 = acc[ai][bj][m][0] * sc, v1 = acc[ai][bj][m][1] * sc;
                    u32x4 w; w.x = cvt_pk_bf16(v0[0], v0[1]); w.y = cvt_pk_bf16(v0[2], v0[3]); w.z = cvt_pk_bf16(v1[0], v1[1]); w.w = cvt_pk_bf16(v1[2], v1[3]);
                    *(u32x4*)(rowp + bj * HALF) = w; } }
    }
};
struct EpiRes {
    static constexpr bool PERM = false, STAGED = false, AFTER_DRAIN = false;
    unsigned short* X; const bf16* Rb; float alpha;
    __device__ __forceinline__ void operator()(const f32x4 (&acc)[2][2][4][2], const Unit& u, int wr, int wc, int fr, int fq) const {
        const int row0 = u.pm * BM + wr * 64 + fr, col0 = u.pn * BM + wc * 32 + 4 * fq;
#pragma unroll
        for (int ai = 0; ai < 2; ++ai)
#pragma unroll
            for (int m = 0; m < 4; ++m) { const size_t off = (size_t)(row0 + ai * HALF + m * 16) * DM + col0;
#pragma unroll
                for (int bj = 0; bj < 2; ++bj)
#pragma unroll
                    for (int n = 0; n < 2; ++n) { const u32x2 r = *(const u32x2*)(Rb + off + bj * HALF + n * 16);
                        const f32x4 x = (f32x4){__builtin_bit_cast(float, r.x << 16), __builtin_bit_cast(float, r.x & 0xffff0000u), __builtin_bit_cast(float, r.y << 16), __builtin_bit_cast(float, r.y & 0xffff0000u)};
                        const f32x4 hv = x * alpha + acc[ai][bj][m][n];
                        u32x2 w;
                        w.x = (unsigned)__builtin_bit_cast(unsigned short, (_Float16)hv[0]) | ((unsigned)__builtin_bit_cast(unsigned short, (_Float16)hv[1]) << 16);
                        w.y = (unsigned)__builtin_bit_cast(unsigned short, (_Float16)hv[2]) | ((unsigned)__builtin_bit_cast(unsigned short, (_Float16)hv[3]) << 16);
                        *(u32x2*)(X + off + bj * HALF + n * 16) = w; } }
    }
};

template <int CTRL> __device__ __forceinline__ float dpp_keep(float old, float src) { return __builtin_bit_cast(float, __builtin_amdgcn_update_dpp(__builtin_bit_cast(int, old), __builtin_bit_cast(int, src), CTRL, 0xf, 0xf, false)); }
struct EpiConvGate {
    static constexpr bool PERM = false, STAGED = true, AFTER_DRAIN = false;
    const __attribute__((address_space(4))) unsigned char* kp; int l;
    LAS unsigned char* lp;
    __device__ __forceinline__ f32x2 load_params(const Unit& u, int tid) const {
        const float* cw = KARG(8 * 22) + (size_t)l * 3 * DFF2; const float* cb = KARG(8 * 23) + (size_t)l * DFF2;
        const int idx = 2 * tid, a = idx >> 7, c = idx & 127, j = 128 * u.pn + c;
        const float* src = ((a & 3) == 3) ? cb + j : cw + (a & 3) * DFF2 + j;
        if (a >= 4) src += DFF;
        return *(const f32x2*)src;
    }
    __device__ __forceinline__ void store_params(const f32x2 v, int buf, int tid) const { *(LAS f32x2*)(lp + buf * 4096 + tid * 8) = v; }
    __device__ __forceinline__ void run_staged(const f32x4 (&acc)[2][2][4][2], const Unit& u, int wr, int wc, int fr, int fq, int buf) const {
        unsigned char* ws_ = (unsigned char*)KARG(224);
        bf16* HH = (bf16*)(ws_ + WS_HH); bf16* UB = (bf16*)(ws_ + WS_UB);
        const LAS f32x4* P = (const LAS f32x4*)(lp + buf * 4096);
#pragma unroll
        for (int n = 0; n < 2; ++n) {
            asm volatile("" ::: "memory");
            const int j = 128 * u.pn + 32 * wc + 16 * n + 4 * fq;
            const int c4 = (32 * wc + 16 * n + 4 * fq) >> 2;
            const f32x4 wg0 = P[c4], wg1 = P[32 + c4], wg2 = P[64 + c4], bg = P[96 + c4], wv0 = P[128 + c4], wv1 = P[160 + c4], wv2 = P[192 + c4], bv = P[224 + c4];
#pragma unroll
            for (int ai = 0; ai < 2; ++ai) {
                const int blk = u.pm * 4 + ai * 2 + wr;
#pragma unroll
                for (int m = 0; m < 4; ++m) {
                    const f32x4 g0 = acc[ai][0][m][n], v0 = acc[ai][1][m][n];
                    const f32x4 gp = acc[ai][0][m > 0 ? m - 1 : 0][n], vp = acc[ai][1][m > 0 ? m - 1 : 0][n];
                    float h[4];
#pragma unroll
                    for (int i = 0; i < 4; ++i) {
                        const float g1 = dpp_keep<0x111>(dpp_ror<1>(gp[i]), g0[i]), g2 = dpp_keep<0x112>(dpp_ror<2>(gp[i]), g0[i]);
                        const float v1 = dpp_keep<0x111>(dpp_ror<1>(vp[i]), v0[i]), v2 = dpp_keep<0x112>(dpp_ror<2>(vp[i]), v0[i]);
                        const float cg = bg[i] + wg0[i] * g2 + wg1[i] * g1 + wg2[i] * g0[i];
                        const float cv = bv[i] + wv0[i] * v2 + wv1[i] * v1 + wv2[i] * v0[i];
                        h[i] = cg * cv * __builtin_amdgcn_rcpf(1.f + __expf(-cg));
                    }
                    const size_t row = (size_t)u.pm * BM + ai * HALF + wr * 64 + m * 16 + fr;
                    if (!(m == 0 && fr < 2)) { u32x2 w; w.x = cvt_pk_bf16(h[0], h[1]); w.y = cvt_pk_bf16(h[2], h[3]); *(u32x2*)(HH + row * DFF + j) = w; }
                    if ((m == 0 && fr < 2) || (m == 3 && fr >= 14)) {
                        const int rr = (m == 0) ? fr : fr - 12;
                        bf16* ub = UB + ((size_t)(blk * 4 + rr) * 2) * DFF + j;
                        u32x2 w; w.x = cvt_pk_bf16(g0[0], g0[1]); w.y = cvt_pk_bf16(g0[2], g0[3]); *(u32x2*)ub = w;
                        w.x = cvt_pk_bf16(v0[0], v0[1]); w.y = cvt_pk_bf16(v0[2], v0[3]); *(u32x2*)(ub + DFF) = w;
                    }
                    asm volatile("" ::: "memory");
                }
            }
        }
    }
};

__device__ __forceinline__ float xrow_sum_fwd(float v) {
    float a = v, b = v;
    asm volatile("s_nop 1\n\tv_permlane16_swap_b32 %0, %1" : "+v"(a), "+v"(b));
    const float s = a + b;
    float c = s, d = s;
    asm volatile("s_nop 1\n\tv_permlane32_swap_b32 %0, %1" : "+v"(c), "+v"(d));
    return c + d;
}
struct PanelStats {
    unsigned long long* xbuf;
    unsigned* cnt;
    float eps;
    __device__ __forceinline__ void run(const f32x4 (&v)[2][2][4][2], const Unit& u, int wr, int wc, int fr, int fq, LAS unsigned char* lds, int wid, int lane) const {
        LAS f32x2* P = (LAS f32x2*)lds;
        LAS f32x2* S = (LAS f32x2*)(lds + 8192);
#pragma unroll
        for (int ai = 0; ai < 2; ++ai)
#pragma unroll
            for (int m = 0; m < 4; ++m) {
                float s = 0.f;
#pragma unroll
                for (int bj = 0; bj < 2; ++bj)
#pragma unroll
                    for (int n = 0; n < 2; ++n) { const f32x4 x = v[ai][bj][m][n]; s += (x[0] + x[1]) + (x[2] + x[3]); }
                s = xrow_sum_fwd(s);
                const float mw = s * (1.0f / 64.0f); float q = 0.f;
#pragma unroll
                for (int bj = 0; bj < 2; ++bj)
#pragma unroll
                    for (int n = 0; n < 2; ++n) { const f32x4 d = v[ai][bj][m][n] - mw; q += (d[0] * d[0] + d[1] * d[1]) + (d[2] * d[2] + d[3] * d[3]); }
                q = xrow_sum_fwd(q);
                if (fq == 0) P[(ai * HALF + wr * 64 + m * 16 + fr) * 4 + wc] = (f32x2){mw, q};
            }
        asm volatile("s_waitcnt lgkmcnt(0)" ::: "memory"); __builtin_amdgcn_s_barrier(); asm volatile("" ::: "memory");
        const int row = wid * 32 + (lane & 31);
        if (lane < 32) {
            const f32x2 a = P[row * 4 + 0], b = P[row * 4 + 1], c = P[row * 4 + 2], d = P[row * 4 + 3];
            const float mt = (a.x + b.x + c.x + d.x) * 0.25f;
            const float da = a.x - mt, db = b.x - mt, dc = c.x - mt, dd = d.x - mt;
            const float m2 = (a.y + b.y) + (c.y + d.y) + 64.0f * ((da * da + db * db) + (dc * dc + dd * dd));
            unsigned long long* slot = xbuf + ((size_t)(u.pm * BM + row) * 4 + u.pn);
            __hip_atomic_store(slot, ((unsigned long long)__builtin_bit_cast(unsigned, m2) << 32) | __builtin_bit_cast(unsigned, mt), __ATOMIC_RELAXED, __HIP_MEMORY_SCOPE_AGENT);
        }
        asm volatile("s_waitcnt vmcnt(0)" ::: "memory");
        if (lane == 0) __hip_atomic_fetch_add(cnt + 64 * u.pm, 1u, __ATOMIC_RELAXED, __HIP_MEMORY_SCOPE_AGENT);
        if (wid == 0) {
            unsigned sp = 0u;
            while ((unsigned)__builtin_amdgcn_readfirstlane(__hip_atomic_load(cnt + 64 * u.pm, __ATOMIC_RELAXED, __HIP_MEMORY_SCOPE_AGENT)) < 32u) { __builtin_amdgcn_s_sleep(2); if (++sp > (1u << 22)) break; }
            __builtin_amdgcn_fence(__ATOMIC_ACQUIRE, "agent");
        }
        asm volatile("s_waitcnt vmcnt(0) lgkmcnt(0)" ::: "memory"); __builtin_amdgcn_s_barrier(); asm volatile("" ::: "memory");
        if (lane < 32) {
            const unsigned long long* slot = xbuf + (size_t)(u.pm * BM + row) * 4; float mt[4], m2[4]; float ms = 0.f;
#pragma unroll
            for (int t = 0; t < 4; ++t) { const unsigned long long w = __hip_atomic_load(slot + t, __ATOMIC_RELAXED, __HIP_MEMORY_SCOPE_AGENT); mt[t] = __builtin_bit_cast(float, (unsigned)w); m2[t] = __builtin_bit_cast(float, (unsigned)(w >> 32)); ms += mt[t]; }
            const float mean = ms * 0.25f; float q = 0.f;
#pragma unroll
            for (int t = 0; t < 4; ++t) { const float dm = mt[t] - mean; q += m2[t] + 256.0f * dm * dm; }
            S[row] = (f32x2){mean, 1.0f / sqrtf(q * (1.0f / 1024.0f) + eps)};
        }
        asm volatile("s_waitcnt lgkmcnt(0)" ::: "memory"); __builtin_amdgcn_s_barrier(); asm volatile("" ::: "memory");
    }
};
struct EpiLnFused {
    static constexpr bool PERM = false, STAGED = false, AFTER_DRAIN = true;
    bf16* XNb; float* outf; bool wr_bf; const float* g; const float* b; float alpha; PanelStats st;
    __device__ __forceinline__ void fused(f32x4 (&acc)[2][2][4][2], const Unit& u, int wr, int wc, int fr, int fq, LAS unsigned char* lds, int wid, int lane) const {
        const LAS f32x2* S = (const LAS f32x2*)(lds + 8192);
        const int col0 = u.pn * BM + wc * 32 + 4 * fq;
#pragma unroll
        for (int ai = 0; ai < 2; ++ai)
#pragma unroll
            for (int m = 0; m < 4; ++m) { const size_t off = (size_t)(u.pm * BM + ai * HALF + wr * 64 + m * 16 + fr) * DM + col0;
#pragma unroll
                for (int bj = 0; bj < 2; ++bj)
#pragma unroll
                    for (int n = 0; n < 2; ++n) { const u32x2 r = *(const u32x2*)(XNb + off + bj * HALF + n * 16);
                        const f32x4 x = (f32x4){__builtin_bit_cast(float, r.x << 16), __builtin_bit_cast(float, r.x & 0xffff0000u), __builtin_bit_cast(float, r.y << 16), __builtin_bit_cast(float, r.y & 0xffff0000u)};
                        acc[ai][bj][m][n] = x * alpha + acc[ai][bj][m][n]; }
                if (m & 1) asm volatile("" ::: "memory"); }
        st.run(acc, u, wr, wc, fr, fq, lds, wid, lane);
#pragma unroll
        for (int bj = 0; bj < 2; ++bj)
#pragma unroll
            for (int n = 0; n < 2; ++n) {
                const f32x4 gv = *(const f32x4*)(g + col0 + bj * HALF + n * 16), bv = *(const f32x4*)(b + col0 + bj * HALF + n * 16);
#pragma unroll
                for (int ai = 0; ai < 2; ++ai)
#pragma unroll
                    for (int m = 0; m < 4; ++m) { const int r = ai * HALF + wr * 64 + m * 16 + fr; const f32x2 sr = S[r]; const size_t off = (size_t)(u.pm * BM + r) * DM + col0 + bj * HALF + n * 16;
                        const f32x4 o = (acc[ai][bj][m][n] - sr.x) * sr.y * gv + bv;
                        if (wr_bf) { u32x2 w; w.x = cvt_pk_bf16(o[0], o[1]); w.y = cvt_pk_bf16(o[2], o[3]); *(u32x2*)(XNb + off) = w; }
                        else *(f32x4*)(outf + off) = o; }
                asm volatile("" ::: "memory"); }
        asm volatile("s_waitcnt lgkmcnt(0)" ::: "memory"); __builtin_amdgcn_s_barrier();
    }
};

template <class Epi>
__device__ __forceinline__ void gemm_phase(LAS unsigned char* lds, const Gemm g, const StaticOrder& S, const Epi& E, int wave_id) {
    unsigned ones_ = ~0u; asm volatile("" : "+s"(ones_));
    int tid = wave_id * 64 + (int)__builtin_amdgcn_mbcnt_hi(ones_, __builtin_amdgcn_mbcnt_lo(ones_, 0u)); asm volatile("" : "+v"(tid));
    const int wid = __builtin_amdgcn_readfirstlane(tid >> 6), lane = tid & 63, wr = wid >> 2, wc = wid & 3, fr = lane & 15, fq = lane >> 4;
    const int K = g.K, nt = K / BK, lda = g.lda;
    unsigned voffA[2], voffB[2];
#pragma unroll
    for (int i = 0; i < 2; ++i) { int R, C; stage_rc(tid * 16 + i * 8192, R, C); const int Rb = Epi::PERM ? ((R & ~31) + perm32(R & 31)) : R;
        voffA[i] = (unsigned)(R * lda + C) * 2u; voffB[i] = (unsigned)(Rb * K + C) * 2u; }
    const size_t kstep = (size_t)(BK * 2);
    const size_t hstepA = (size_t)HALF * lda * 2, hstepB = (size_t)HALF * K * 2;
    const size_t tstepA = 2 * hstepA, tstepB = 2 * hstepB;
    const unsigned ldsw = (unsigned)wid * 1024u;
    const int aoff = lds_byte(wr * 64 + fr, fq * 8), boff = lds_byte(wc * 32 + fr, fq * 8);
#define PG8_SA(b, h) (((b) * 2 + (h)) * HTB)
#define PG8_SB(b, h) ((4 + (b) * 2 + (h)) * HTB)
#define PG8_STAGE(bufoff, gbase, voff) do { _Pragma("unroll") for (int _i = 0; _i < 2; ++_i) \
        __builtin_amdgcn_global_load_lds((const unsigned*)((const char*)(gbase) + (voff)[_i]), (LAS unsigned*)(lds + (bufoff) + ldsw + _i * 8192), 16, 0, 0); } while (0)
#define PG8_LDA(dst, b, h) do { _Pragma("unroll") for (int m = 0; m < 4; ++m) _Pragma("unroll") for (int k = 0; k < 2; ++k) dst[m][k] = *(const LAS bf16x8*)(lds + PG8_SA(b, h) + aoff + m * 2048 + k * 1024); } while (0)
#define PG8_LDB(dst, b, h) do { _Pragma("unroll") for (int n = 0; n < 2; ++n) _Pragma("unroll") for (int k = 0; k < 2; ++k) dst[n][k] = *(const LAS bf16x8*)(lds + PG8_SB(b, h) + boff + n * 2048 + k * 1024); } while (0)
#define PG8_MMA(ai, bj, At, Bt) do { __builtin_amdgcn_s_setprio(1); _Pragma("unroll") for (int m = 0; m < 4; ++m) _Pragma("unroll") for (int n = 0; n < 2; ++n) _Pragma("unroll") for (int k = 0; k < 2; ++k) \
        acc[ai][bj][m][n] = __builtin_amdgcn_mfma_f32_16x16x32_bf16(Bt[n][k], At[m][k], acc[ai][bj][m][n], 0, 0, 0); __builtin_amdgcn_s_setprio(0); } while (0)
#define PG8_WAIT_V(n) asm volatile("s_waitcnt vmcnt(" #n ")" ::: "memory")
#define PG8_WAIT_L(n) asm volatile("s_waitcnt lgkmcnt(" #n ")" ::: "memory")
#define PG8_BAR __builtin_amdgcn_s_barrier()
#define PG8_SCHED __builtin_amdgcn_sched_barrier(0)
    Unit cur, nxt; int ui = 0;
    if (!S.next(0, cur)) return;
    f32x4 acc[2][2][4][2];
#pragma unroll
    for (int a = 0; a < 2; ++a)
#pragma unroll
        for (int b = 0; b < 2; ++b)
#pragma unroll
            for (int m = 0; m < 4; ++m)
#pragma unroll
                for (int n = 0; n < 2; ++n) acc[a][b][m][n] = (f32x4){0.f, 0.f, 0.f, 0.f};
    bf16x8 At[4][2], B0[2][2], B1[2][2];
    const char* cA = (const char*)g.A + (size_t)cur.pm * tstepA; const char* cB = (const char*)g.Bt + (size_t)cur.pn * tstepB;
    if constexpr (Epi::STAGED) { const f32x2 p0_ = E.load_params(cur, tid); E.store_params(p0_, 0, tid); }
    PG8_STAGE(PG8_SB(0, 0), cB, voffB); PG8_STAGE(PG8_SB(0, 1), cB + hstepB, voffB); PG8_STAGE(PG8_SA(0, 0), cA, voffA); PG8_STAGE(PG8_SA(0, 1), cA + hstepA, voffA);
    if (wr == 1) PG8_BAR;
    PG8_WAIT_V(2); PG8_BAR;
    PG8_STAGE(PG8_SB(1, 0), cB + kstep, voffB); PG8_STAGE(PG8_SA(1, 0), cA + kstep, voffA); PG8_STAGE(PG8_SB(1, 1), cB + hstepB + kstep, voffB);
    PG8_WAIT_V(6); PG8_BAR;
    for (;;) {
        const bool has_next = S.next(ui + 1, nxt);
        const char* nA = has_next ? (const char*)g.A + (size_t)nxt.pm * tstepA : cA; const char* nB = has_next ? (const char*)g.Bt + (size_t)nxt.pn * tstepB : cB;
        for (int t = 0; t < nt; t += 2) {
            const bool last = (t == nt - 2);
            const char* a1 = cA + (size_t)(t + 1) * kstep;
            const char* a2 = last ? nA : cA + (size_t)(t + 2) * kstep; const char* b2 = last ? nB : cB + (size_t)(t + 2) * kstep;
            const char* a3 = a2 + kstep; const char* b3 = b2 + kstep;
            PG8_LDB(B0, 0, 0); PG8_LDB(B1, 0, 1); PG8_SCHED; PG8_LDA(At, 0, 0); PG8_STAGE(PG8_SA(1, 1), a1 + hstepA, voffA);
            PG8_WAIT_V(8); PG8_WAIT_L(0); PG8_BAR; PG8_MMA(0, 0, At, B0); PG8_MMA(0, 1, At, B1); PG8_BAR; PG8_SCHED;
            PG8_LDA(At, 0, 1); PG8_STAGE(PG8_SB(0, 0), b2, voffB); PG8_STAGE(PG8_SB(0, 1), b2 + hstepB, voffB); PG8_STAGE(PG8_SA(0, 0), a2, voffA);
            PG8_WAIT_V(8); PG8_WAIT_L(0); PG8_BAR; PG8_MMA(1, 0, At, B0); PG8_MMA(1, 1, At, B1); PG8_BAR; PG8_SCHED;
            PG8_LDB(B0, 1, 0); PG8_LDB(B1, 1, 1); PG8_SCHED; PG8_LDA(At, 1, 0); PG8_STAGE(PG8_SA(0, 1), a2 + hstepA, voffA);
            PG8_WAIT_V(8); PG8_WAIT_L(0); PG8_BAR; PG8_MMA(0, 0, At, B0); PG8_MMA(0, 1, At, B1); PG8_BAR; PG8_SCHED;
            PG8_LDA(At, 1, 1); PG8_STAGE(PG8_SB(1, 0), b3, voffB); PG8_STAGE(PG8_SB(1, 1), b3 + hstepB, voffB); PG8_STAGE(PG8_SA(1, 0), a3, voffA);
            PG8_WAIT_V(8); PG8_WAIT_L(0); PG8_BAR; PG8_MMA(1, 0, At, B0); PG8_MMA(1, 1, At, B1); PG8_BAR; PG8_SCHED;
        }
        if (wr == 0) PG8_BAR;
        { unsigned o2 = ~0u; asm volatile("" : "+s"(o2));
          const int lane2 = (int)__builtin_amdgcn_mbcnt_hi(o2, __builtin_amdgcn_mbcnt_lo(o2, 0u));
          if constexpr (Epi::AFTER_DRAIN) { (void)lane2; }
          else if constexpr (Epi::STAGED) {
              const int tid2 = wid * 64 + lane2;
              f32x2 pn_ = (f32x2){0.f, 0.f}; if (has_next) pn_ = E.load_params(nxt, tid2);
              E.run_staged(acc, cur, wr, wc, lane2 & 15, lane2 >> 4, ui & 1);
              if (has_next) E.store_params(pn_, (ui + 1) & 1, tid2);
          } else { E(acc, cur, wr, wc, lane2 & 15, lane2 >> 4); } }
        if (!has_next) break;
#pragma unroll
        for (int a = 0; a < 2; ++a)
#pragma unroll
            for (int b = 0; b < 2; ++b)
#pragma unroll
                for (int m = 0; m < 4; ++m)
#pragma unroll
                    for (int n = 0; n < 2; ++n) acc[a][b][m][n] = (f32x4){0.f, 0.f, 0.f, 0.f};
        cur = nxt; cA = nA; cB = nB; ++ui;
        if (wr == 1) PG8_BAR;
    }
    PG8_WAIT_V(0);
    PG8_BAR;
    if constexpr (Epi::AFTER_DRAIN) {
        unsigned o3 = ~0u; asm volatile("" : "+s"(o3));
        const int lane3 = (int)__builtin_amdgcn_mbcnt_hi(o3, __builtin_amdgcn_mbcnt_lo(o3, 0u));
        E.fused(acc, cur, wr, wc, lane3 & 15, lane3 >> 4, lds, wid, lane3);
    }
#undef PG8_SA
#undef PG8_SB
#undef PG8_STAGE
#undef PG8_LDA
#undef PG8_LDB
#undef PG8_MMA
#undef PG8_WAIT_V
#undef PG8_WAIT_L
#undef PG8_BAR
#undef PG8_SCHED
}
}

__device__ __forceinline__ unsigned f2bf(float f) { unsigned u = __builtin_bit_cast(unsigned, f); return (u + 0x7fffu + ((u >> 16) & 1u)) >> 16; }
__device__ __forceinline__ unsigned pk2(float lo, float hi) { return f2bf(lo) | (f2bf(hi) << 16); }
__device__ __forceinline__ float bf2f(unsigned u) { return __builtin_bit_cast(float, u << 16); }
__device__ __forceinline__ float bflo(unsigned w) { return __builtin_bit_cast(float, w << 16); }
__device__ __forceinline__ float bfhi(unsigned w) { return __builtin_bit_cast(float, w & 0xffff0000u); }
__device__ __forceinline__ float wave_sum(float v) {
#pragma unroll
    for (int o = 1; o < 64; o <<= 1) v += __shfl_xor(v, o);
    return v;
}
__device__ __forceinline__ float row16_sum(float v) { v += __shfl_xor(v, 1); v += __shfl_xor(v, 2); v += __shfl_xor(v, 4); v += __shfl_xor(v, 8); return v; }
__device__ __forceinline__ float row16_max(float v) { v = fmaxf(v, __shfl_xor(v, 1)); v = fmaxf(v, __shfl_xor(v, 2)); v = fmaxf(v, __shfl_xor(v, 4)); v = fmaxf(v, __shfl_xor(v, 8)); return v; }
__device__ __forceinline__ float sigmoidf_(float x) { return __builtin_amdgcn_rcpf(1.f + __expf(-x)); }
__device__ __forceinline__ void unpack8(const u32x4 w, float (&o)[8]) { o[0] = bflo(w.x); o[1] = bfhi(w.x); o[2] = bflo(w.y); o[3] = bfhi(w.y); o[4] = bflo(w.z); o[5] = bfhi(w.z); o[6] = bflo(w.w); o[7] = bfhi(w.w); }
__device__ __forceinline__ u32x4 pack8(const float (&o)[8]) { u32x4 w; w.x = pk2(o[0], o[1]); w.y = pk2(o[2], o[3]); w.z = pk2(o[4], o[5]); w.w = pk2(o[6], o[7]); return w; }
#define LDS_WAIT() asm volatile("s_waitcnt lgkmcnt(0)" ::: "memory")

__device__ __forceinline__ int map_row(int n, int mode) {
    if (mode == 1) return n < 1408 ? n : n + 128;
    if (mode == 2) { if (n < DFF) return 256 * (n >> 7) + (n & 127); const int q = n - DFF; return 256 * (q >> 7) + 128 + (q & 127); }
    return n;
}
__device__ __forceinline__ void p0_transpose_item(const float* W, int K, int N, bf16* WT, int mode, LAS float* scr, int item, int lane) {
    const int nblk = N / 32, kb = item / nblk, nb = item % nblk, k0 = 64 * kb, n0 = 32 * nb;
#pragma unroll 8
    for (int i = 0; i < 32; ++i) { const int kk = 2 * i + (lane >> 5); scr[kk * 33 + (lane & 31)] = W[(size_t)(k0 + kk) * N + n0 + (lane & 31)]; }
    LDS_WAIT();
    const int c = lane & 7;
#pragma unroll
    for (int j = 0; j < 4; ++j) { const int n = (lane >> 3) + 8 * j; const LAS float* s = scr + (8 * c) * 33 + n;
        u32x4 o; o.x = pk2(s[0 * 33], s[1 * 33]); o.y = pk2(s[2 * 33], s[3 * 33]); o.z = pk2(s[4 * 33], s[5 * 33]); o.w = pk2(s[6 * 33], s[7 * 33]);
        *(u32x4*)(WT + (size_t)map_row(n0 + n, mode) * K + k0 + 8 * c) = o; }
    LDS_WAIT();
}
__device__ __forceinline__ void ln_row(const float* xrow, const float* g, const float* bta, float* orow, bf16* brow, int lane) {
    const f32x4* xr = (const f32x4*)xrow + lane;
    f32x4 v[4]; float s = 0.f;
#pragma unroll
    for (int j = 0; j < 4; ++j) { v[j] = xr[64 * j]; s += (v[j].x + v[j].y) + (v[j].z + v[j].w); }
    const float mean = wave_sum(s) * (1.f / DM); float s2 = 0.f;
#pragma unroll
    for (int j = 0; j < 4; ++j) { v[j] = v[j] - mean; s2 += (v[j].x * v[j].x + v[j].y * v[j].y) + (v[j].z * v[j].z + v[j].w * v[j].w); }
    const float rstd = 1.f / sqrtf(wave_sum(s2) * (1.f / DM) + LN_EPS);
#pragma unroll
    for (int j = 0; j < 4; ++j) { const f32x4 gg = *((const f32x4*)g + lane + 64 * j), bb = *((const f32x4*)bta + lane + 64 * j);
        const f32x4 o = v[j] * rstd * gg + bb;
        if (orow) *((f32x4*)orow + lane + 64 * j) = o;
        if (brow) { u32x2 w; w.x = pk2(o.x, o.y); w.y = pk2(o.z, o.w); *((u32x2*)brow + lane + 64 * j) = w; } }
}

__device__ __forceinline__ float wsum_dpp(float v);
__device__ __forceinline__ float wsum_dpp(float v);
__device__ __forceinline__ float h2f_lo(unsigned w) { return (float)__builtin_bit_cast(_Float16, (unsigned short)(w & 0xffffu)); }
__device__ __forceinline__ float h2f_hi(unsigned w) { return (float)__builtin_bit_cast(_Float16, (unsigned short)(w >> 16)); }
struct Rows2h { u32x4 q0, q1, r0, r1; };
__device__ __forceinline__ Rows2h ln_load2h(const unsigned short* x0, const unsigned short* x1, int lane) {
    Rows2h r; r.q0 = *((const u32x4*)x0 + 2 * lane); r.q1 = *((const u32x4*)x0 + 2 * lane + 1); r.r0 = *((const u32x4*)x1 + 2 * lane); r.r1 = *((const u32x4*)x1 + 2 * lane + 1); return r;
}
__device__ __forceinline__ void ln_row2h(const Rows2h& in, const float* g, const float* bta, float* o0, float* o1, bf16* b0, bf16* b1, int lane) {
    const u32x4 q0 = in.q0, q1 = in.q1, r0 = in.r0, r1 = in.r1;
    float v[16], w[16];
    { const unsigned qa[8] = {q0.x, q0.y, q0.z, q0.w, q1.x, q1.y, q1.z, q1.w}, ra[8] = {r0.x, r0.y, r0.z, r0.w, r1.x, r1.y, r1.z, r1.w};
#pragma unroll
      for (int i = 0; i < 8; ++i) { v[2 * i] = h2f_lo(qa[i]); v[2 * i + 1] = h2f_hi(qa[i]); w[2 * i] = h2f_lo(ra[i]); w[2 * i + 1] = h2f_hi(ra[i]); } }
    float s = 0.f, t = 0.f;
#pragma unroll
    for (int i = 0; i < 16; ++i) { s += v[i]; t += w[i]; }
    const float mean0 = wsum_dpp(s) * (1.f / DM), mean1 = wsum_dpp(t) * (1.f / DM); float s2 = 0.f, t2 = 0.f;
#pragma unroll
    for (int i = 0; i < 16; ++i) { v[i] -= mean0; w[i] -= mean1; s2 += v[i] * v[i]; t2 += w[i] * w[i]; }
    const float rstd0 = 1.f / sqrtf(wsum_dpp(s2) * (1.f / DM) + LN_EPS), rstd1 = 1.f / sqrtf(wsum_dpp(t2) * (1.f / DM) + LN_EPS);
#pragma unroll
    for (int j = 0; j < 4; ++j) { const f32x4 gg = *((const f32x4*)g + 4 * lane + j), bb = *((const f32x4*)bta + 4 * lane + j);
        const f32x4 p = (f32x4){v[4 * j], v[4 * j + 1], v[4 * j + 2], v[4 * j + 3]} * rstd0 * gg + bb, q = (f32x4){w[4 * j], w[4 * j + 1], w[4 * j + 2], w[4 * j + 3]} * rstd1 * gg + bb;
        if (o0) { *((f32x4*)o0 + 4 * lane + j) = p; *((f32x4*)o1 + 4 * lane + j) = q; }
        if (b0) { u32x2 z; z.x = pk2(p.x, p.y); z.y = pk2(p.z, p.w); *((u32x2*)b0 + 4 * lane + j) = z; z.x = pk2(q.x, q.y); z.y = pk2(q.z, q.w); *((u32x2*)b1 + 4 * lane + j) = z; } }
}
struct Rows2f { f32x4 v[4], w[4]; };
__device__ __forceinline__ Rows2f ln_load2f(const float* x0, const float* x1, int lane) {
    Rows2f r; const f32x4* xr0 = (const f32x4*)x0 + lane; const f32x4* xr1 = (const f32x4*)x1 + lane;
#pragma unroll
    for (int j = 0; j < 4; ++j) { r.v[j] = xr0[64 * j]; r.w[j] = xr1[64 * j]; }
    return r;
}
__device__ __forceinline__ void ln_row2(const Rows2f& in, const float* g, const float* bta, float* o0, float* o1, bf16* b0, bf16* b1, int lane) {
    f32x4 v[4], w[4]; float s = 0.f, t = 0.f;
#pragma unroll
    for (int j = 0; j < 4; ++j) { v[j] = in.v[j]; w[j] = in.w[j]; }
#pragma unroll
    for (int j = 0; j < 4; ++j) { s += (v[j].x + v[j].y) + (v[j].z + v[j].w); t += (w[j].x + w[j].y) + (w[j].z + w[j].w); }
    const float mean0 = wsum_dpp(s) * (1.f / DM), mean1 = wsum_dpp(t) * (1.f / DM); float s2 = 0.f, t2 = 0.f;
#pragma unroll
    for (int j = 0; j < 4; ++j) { v[j] = v[j] - mean0; w[j] = w[j] - mean1;
        s2 += (v[j].x * v[j].x + v[j].y * v[j].y) + (v[j].z * v[j].z + v[j].w * v[j].w); t2 += (w[j].x * w[j].x + w[j].y * w[j].y) + (w[j].z * w[j].z + w[j].w * w[j].w); }
    const float rstd0 = 1.f / sqrtf(wsum_dpp(s2) * (1.f / DM) + LN_EPS), rstd1 = 1.f / sqrtf(wsum_dpp(t2) * (1.f / DM) + LN_EPS);
#pragma unroll
    for (int j = 0; j < 4; ++j) { const f32x4 gg = *((const f32x4*)g + lane + 64 * j), bb = *((const f32x4*)bta + lane + 64 * j);
        const f32x4 p = v[j] * rstd0 * gg + bb, q = w[j] * rstd1 * gg + bb;
        if (o0) { *((f32x4*)o0 + lane + 64 * j) = p; *((f32x4*)o1 + lane + 64 * j) = q; }
        if (b0) { u32x2 z; z.x = pk2(p.x, p.y); z.y = pk2(p.z, p.w); *((u32x2*)b0 + lane + 64 * j) = z; z.x = pk2(q.x, q.y); z.y = pk2(q.z, q.w); *((u32x2*)b1 + lane + 64 * j) = z; } }
}

__device__ __forceinline__ float xrow_sum(float v) {
    float a = v, b = v;
    asm volatile("s_nop 1\n\tv_permlane16_swap_b32 %0, %1" : "+v"(a), "+v"(b));
    const float s = a + b;
    float c = s, d = s;
    asm volatile("s_nop 1\n\tv_permlane32_swap_b32 %0, %1" : "+v"(c), "+v"(d));
    return c + d;
}
__device__ __forceinline__ float hlo(unsigned w) { return (float)__builtin_bit_cast(_Float16, (unsigned short)(w & 0xffffu)); }
__device__ __forceinline__ float hhi(unsigned w) { return (float)__builtin_bit_cast(_Float16, (unsigned short)(w >> 16)); }
__device__ __forceinline__ unsigned pkh2(float lo, float hi) { return (unsigned)__builtin_bit_cast(unsigned short, (_Float16)lo) | ((unsigned)__builtin_bit_cast(unsigned short, (_Float16)hi) << 16); }
constexpr int REC_STEP = 640;
template <int I> __device__ __forceinline__ float bc16(float x) {
    return __builtin_bit_cast(float, __builtin_amdgcn_update_dpp(0, __builtin_bit_cast(int, x), 0x150 + I, 0xf, 0xf, true));
}
__device__ __forceinline__ void rwkv_scan(int bh, int wv, int lane, const bf16* Zr, const unsigned char* REC, bf16* Y, const float* mu) {
    const int b = bh / 6, h = bh % 6, vl = lane & 15, kq = lane >> 4;
    const size_t m0 = (size_t)b * SEQ;
    const unsigned short* prec = (const unsigned short*)(REC + (size_t)bh * SEQ * REC_STEP) + lane;
    const bf16* pv = Zr + m0 * ZR_P + 768 + h * 64 + 16 * wv + vl;
    bf16* py = Y + m0 * Y_P + h * 64 + 16 * wv + vl;
    const float muv = mu[768 + h * 64 + 16 * wv + vl];
    float s[16];
#pragma unroll
    for (int i = 0; i < 16; ++i) s[i] = 0.f;
    constexpr int PD = 16;
    unsigned br[PD], bv[PD], be[PD], bb[PD], bk[PD], bn[PD];
#pragma unroll
    for (int j = 0; j < PD; ++j) { br[j] = prec[(size_t)j * 320]; be[j] = prec[(size_t)j * 320 + 64]; bk[j] = prec[(size_t)j * 320 + 128]; bn[j] = prec[(size_t)j * 320 + 192]; bb[j] = prec[(size_t)j * 320 + 256]; bv[j] = pv[(size_t)j * ZR_P]; }
    float vprev = 0.f;
    for (int t0 = 0; t0 < SEQ; t0 += PD) {
#pragma unroll
        for (int j = 0; j < PD; ++j) {
            const int t = t0 + j;
            const float rs = hlo(br[j]), xd = hlo(be[j]), kv = hlo(bk[j]), av = -hlo(bn[j]), bvv = hlo(bb[j]), vr = bf2f(bv[j]);
            { const int tn = (t + PD < SEQ) ? t + PD : SEQ - 1;
              br[j] = prec[(size_t)tn * 320]; be[j] = prec[(size_t)tn * 320 + 64]; bk[j] = prec[(size_t)tn * 320 + 128]; bn[j] = prec[(size_t)tn * 320 + 192]; bb[j] = prec[(size_t)tn * 320 + 256]; bv[j] = pv[(size_t)tn * ZR_P]; }
            const float vs = vr + (vprev - vr) * muv; vprev = vr;
            const float dec = 1.f - xd;
            float sa0, sa1;
            asm volatile(
                "s_nop 1\n\t"
                "v_mul_f32_dpp %0, %2, %3 row_newbcast:0 row_mask:0xf bank_mask:0xf\n\t"
                "v_mul_f32_dpp %1, %2, %4 row_newbcast:1 row_mask:0xf bank_mask:0xf\n\t"
                "v_fmac_f32_dpp %0, %2, %5 row_newbcast:2 row_mask:0xf bank_mask:0xf\n\t"
                "v_fmac_f32_dpp %1, %2, %6 row_newbcast:3 row_mask:0xf bank_mask:0xf\n\t"
                "v_fmac_f32_dpp %0, %2, %7 row_newbcast:4 row_mask:0xf bank_mask:0xf\n\t"
                "v_fmac_f32_dpp %1, %2, %8 row_newbcast:5 row_mask:0xf bank_mask:0xf\n\t"
                "v_fmac_f32_dpp %0, %2, %9 row_newbcast:6 row_mask:0xf bank_mask:0xf\n\t"
                "v_fmac_f32_dpp %1, %2, %10 row_newbcast:7 row_mask:0xf bank_mask:0xf\n\t"
                "v_fmac_f32_dpp %0, %2, %11 row_newbcast:8 row_mask:0xf bank_mask:0xf\n\t"
                "v_fmac_f32_dpp %1, %2, %12 row_newbcast:9 row_mask:0xf bank_mask:0xf\n\t"
                "v_fmac_f32_dpp %0, %2, %13 row_newbcast:10 row_mask:0xf bank_mask:0xf\n\t"
                "v_fmac_f32_dpp %1, %2, %14 row_newbcast:11 row_mask:0xf bank_mask:0xf\n\t"
                "v_fmac_f32_dpp %0, %2, %15 row_newbcast:12 row_mask:0xf bank_mask:0xf\n\t"
                "v_fmac_f32_dpp %1, %2, %16 row_newbcast:13 row_mask:0xf bank_mask:0xf\n\t"
                "v_fmac_f32_dpp %0, %2, %17 row_newbcast:14 row_mask:0xf bank_mask:0xf\n\t"
                "v_fmac_f32_dpp %1, %2, %18 row_newbcast:15 row_mask:0xf bank_mask:0xf\n\t"
                : "=&v"(sa0), "=&v"(sa1) : "v"(av), "v"(s[0]), "v"(s[1]), "v"(s[2]), "v"(s[3]), "v"(s[4]), "v"(s[5]), "v"(s[6]), "v"(s[7]), "v"(s[8]), "v"(s[9]), "v"(s[10]), "v"(s[11]), "v"(s[12]), "v"(s[13]), "v"(s[14]), "v"(s[15]));
            float sa = xrow_sum(sa0 + sa1);
            float y0 = 0.f, y1 = 0.f;
            asm volatile(
                "s_nop 1\n\t"
                "v_mul_f32_dpp %[s0], %[dec], %[s0] row_newbcast:0 row_mask:0xf bank_mask:0xf\n\t"
                "v_mul_f32_dpp %[s1], %[dec], %[s1] row_newbcast:1 row_mask:0xf bank_mask:0xf\n\t"
                "v_fmac_f32_dpp %[s0], %[bv], %[sa] row_newbcast:0 row_mask:0xf bank_mask:0xf\n\t"
                "v_fmac_f32_dpp %[s1], %[bv], %[sa] row_newbcast:1 row_mask:0xf bank_mask:0xf\n\t"
                "v_fmac_f32_dpp %[s0], %[kv], %[vs] row_newbcast:0 row_mask:0xf bank_mask:0xf\n\t"
                "v_fmac_f32_dpp %[s1], %[kv], %[vs] row_newbcast:1 row_mask:0xf bank_mask:0xf\n\t"
                "v_fmac_f32_dpp %[y], %[rs], %[s0] row_newbcast:0 row_mask:0xf bank_mask:0xf\n\t"
                "v_fmac_f32_dpp %[y], %[rs], %[s1] row_newbcast:1 row_mask:0xf bank_mask:0xf\n\t"
                "v_mul_f32_dpp %[s2], %[dec], %[s2] row_newbcast:2 row_mask:0xf bank_mask:0xf\n\t"
                "v_mul_f32_dpp %[s3], %[dec], %[s3] row_newbcast:3 row_mask:0xf bank_mask:0xf\n\t"
                "v_fmac_f32_dpp %[s2], %[bv], %[sa] row_newbcast:2 row_mask:0xf bank_mask:0xf\n\t"
                "v_fmac_f32_dpp %[s3], %[bv], %[sa] row_newbcast:3 row_mask:0xf bank_mask:0xf\n\t"
                "v_fmac_f32_dpp %[s2], %[kv], %[vs] row_newbcast:2 row_mask:0xf bank_mask:0xf\n\t"
                "v_fmac_f32_dpp %[s3], %[kv], %[vs] row_newbcast:3 row_mask:0xf bank_mask:0xf\n\t"
                "v_fmac_f32_dpp %[y], %[rs], %[s2] row_newbcast:2 row_mask:0xf bank_mask:0xf\n\t"
                "v_fmac_f32_dpp %[y], %[rs], %[s3] row_newbcast:3 row_mask:0xf bank_mask:0xf\n\t"
                "v_mul_f32_dpp %[s4], %[dec], %[s4] row_newbcast:4 row_mask:0xf bank_mask:0xf\n\t"
                "v_mul_f32_dpp %[s5], %[dec], %[s5] row_newbcast:5 row_mask:0xf bank_mask:0xf\n\t"
                "v_fmac_f32_dpp %[s4], %[bv], %[sa] row_newbcast:4 row_mask:0xf bank_mask:0xf\n\t"
                "v_fmac_f32_dpp %[s5], %[bv], %[sa] row_newbcast:5 row_mask:0xf bank_mask:0xf\n\t"
                "v_fmac_f32_dpp %[s4], %[kv], %[vs] row_newbcast:4 row_mask:0xf bank_mask:0xf\n\t"
                "v_fmac_f32_dpp %[s5], %[kv], %[vs] row_newbcast:5 row_mask:0xf bank_mask:0xf\n\t"
                "v_fmac_f32_dpp %[y], %[rs], %[s4] row_newbcast:4 row_mask:0xf bank_mask:0xf\n\t"
                "v_fmac_f32_dpp %[y], %[rs], %[s5] row_newbcast:5 row_mask:0xf bank_mask:0xf\n\t"
                "v_mul_f32_dpp %[s6], %[dec], %[s6] row_newbcast:6 row_mask:0xf bank_mask:0xf\n\t"
                "v_mul_f32_dpp %[s7], %[dec], %[s7] row_newbcast:7 row_mask:0xf bank_mask:0xf\n\t"
                "v_fmac_f32_dpp %[s6], %[bv], %[sa] row_newbcast:6 row_mask:0xf bank_mask:0xf\n\t"
                "v_fmac_f32_dpp %[s7], %[bv], %[sa] row_newbcast:7 row_mask:0xf bank_mask:0xf\n\t"
                "v_fmac_f32_dpp %[s6], %[kv], %[vs] row_newbcast:6 row_mask:0xf bank_mask:0xf\n\t"
                "v_fmac_f32_dpp %[s7], %[kv], %[vs] row_newbcast:7 row_mask:0xf bank_mask:0xf\n\t"
                "v_fmac_f32_dpp %[y], %[rs], %[s6] row_newbcast:6 row_mask:0xf bank_mask:0xf\n\t"
                "v_fmac_f32_dpp %[y], %[rs], %[s7] row_newbcast:7 row_mask:0xf bank_mask:0xf\n\t"
                : [s0]"+v"(s[0]), [s1]"+v"(s[1]), [s2]"+v"(s[2]), [s3]"+v"(s[3]), [s4]"+v"(s[4]), [s5]"+v"(s[5]), [s6]"+v"(s[6]), [s7]"+v"(s[7]), [y]"+v"(y0)
                : [dec]"v"(dec), [bv]"v"(bvv), [kv]"v"(kv), [rs]"v"(rs), [sa]"v"(sa), [vs]"v"(vs));
            asm volatile(
                "s_nop 1\n\t"
                "v_mul_f32_dpp %[s8], %[dec], %[s8] row_newbcast:8 row_mask:0xf bank_mask:0xf\n\t"
                "v_mul_f32_dpp %[s9], %[dec], %[s9] row_newbcast:9 row_mask:0xf bank_mask:0xf\n\t"
                "v_fmac_f32_dpp %[s8], %[bv], %[sa] row_newbcast:8 row_mask:0xf bank_mask:0xf\n\t"
                "v_fmac_f32_dpp %[s9], %[bv], %[sa] row_newbcast:9 row_mask:0xf bank_mask:0xf\n\t"
                "v_fmac_f32_dpp %[s8], %[kv], %[vs] row_newbcast:8 row_mask:0xf bank_mask:0xf\n\t"
                "v_fmac_f32_dpp %[s9], %[kv], %[vs] row_newbcast:9 row_mask:0xf bank_mask:0xf\n\t"
                "v_fmac_f32_dpp %[y], %[rs], %[s8] row_newbcast:8 row_mask:0xf bank_mask:0xf\n\t"
                "v_fmac_f32_dpp %[y], %[rs], %[s9] row_newbcast:9 row_mask:0xf bank_mask:0xf\n\t"
                "v_mul_f32_dpp %[s10], %[dec], %[s10] row_newbcast:10 row_mask:0xf bank_mask:0xf\n\t"
                "v_mul_f32_dpp %[s11], %[dec], %[s11] row_newbcast:11 row_mask:0xf bank_mask:0xf\n\t"
                "v_fmac_f32_dpp %[s10], %[bv], %[sa] row_newbcast:10 row_mask:0xf bank_mask:0xf\n\t"
                "v_fmac_f32_dpp %[s11], %[bv], %[sa] row_newbcast:11 row_mask:0xf bank_mask:0xf\n\t"
                "v_fmac_f32_dpp %[s10], %[kv], %[vs] row_newbcast:10 row_mask:0xf bank_mask:0xf\n\t"
                "v_fmac_f32_dpp %[s11], %[kv], %[vs] row_newbcast:11 row_mask:0xf bank_mask:0xf\n\t"
                "v_fmac_f32_dpp %[y], %[rs], %[s10] row_newbcast:10 row_mask:0xf bank_mask:0xf\n\t"
                "v_fmac_f32_dpp %[y], %[rs], %[s11] row_newbcast:11 row_mask:0xf bank_mask:0xf\n\t"
                "v_mul_f32_dpp %[s12], %[dec], %[s12] row_newbcast:12 row_mask:0xf bank_mask:0xf\n\t"
                "v_mul_f32_dpp %[s13], %[dec], %[s13] row_newbcast:13 row_mask:0xf bank_mask:0xf\n\t"
                "v_fmac_f32_dpp %[s12], %[bv], %[sa] row_newbcast:12 row_mask:0xf bank_mask:0xf\n\t"
                "v_fmac_f32_dpp %[s13], %[bv], %[sa] row_newbcast:13 row_mask:0xf bank_mask:0xf\n\t"
                "v_fmac_f32_dpp %[s12], %[kv], %[vs] row_newbcast:12 row_mask:0xf bank_mask:0xf\n\t"
                "v_fmac_f32_dpp %[s13], %[kv], %[vs] row_newbcast:13 row_mask:0xf bank_mask:0xf\n\t"
                "v_fmac_f32_dpp %[y], %[rs], %[s12] row_newbcast:12 row_mask:0xf bank_mask:0xf\n\t"
                "v_fmac_f32_dpp %[y], %[rs], %[s13] row_newbcast:13 row_mask:0xf bank_mask:0xf\n\t"
                "v_mul_f32_dpp %[s14], %[dec], %[s14] row_newbcast:14 row_mask:0xf bank_mask:0xf\n\t"
                "v_mul_f32_dpp %[s15], %[dec], %[s15] row_newbcast:15 row_mask:0xf bank_mask:0xf\n\t"
                "v_fmac_f32_dpp %[s14], %[bv], %[sa] row_newbcast:14 row_mask:0xf bank_mask:0xf\n\t"
                "v_fmac_f32_dpp %[s15], %[bv], %[sa] row_newbcast:15 row_mask:0xf bank_mask:0xf\n\t"
                "v_fmac_f32_dpp %[s14], %[kv], %[vs] row_newbcast:14 row_mask:0xf bank_mask:0xf\n\t"
                "v_fmac_f32_dpp %[s15], %[kv], %[vs] row_newbcast:15 row_mask:0xf bank_mask:0xf\n\t"
                "v_fmac_f32_dpp %[y], %[rs], %[s14] row_newbcast:14 row_mask:0xf bank_mask:0xf\n\t"
                "v_fmac_f32_dpp %[y], %[rs], %[s15] row_newbcast:15 row_mask:0xf bank_mask:0xf\n\t"
                : [s8]"+v"(s[8]), [s9]"+v"(s[9]), [s10]"+v"(s[10]), [s11]"+v"(s[11]), [s12]"+v"(s[12]), [s13]"+v"(s[13]), [s14]"+v"(s[14]), [s15]"+v"(s[15]), [y]"+v"(y1)
                : [dec]"v"(dec), [bv]"v"(bvv), [kv]"v"(kv), [rs]"v"(rs), [sa]"v"(sa), [vs]"v"(vs));
            const float y = xrow_sum(y0 + y1);
            if (kq == 0) py[(size_t)t * Y_P] = (bf16)f2bf(y);
        }
    }
}

__device__ __forceinline__ float row16_allsum(float v) { v += dpp_ror<8>(v); v += dpp_ror<4>(v); v += dpp_ror<2>(v); v += dpp_ror<1>(v); return v; }
__device__ __forceinline__ float wave_allsum(float v) { return xrow_sum(row16_allsum(v)); }
__device__ __forceinline__ float wsum_dpp(float v) { return wave_allsum(v); }
__device__ __forceinline__ float row16_allmax(float v) { v = fmaxf(v, dpp_ror<8>(v)); v = fmaxf(v, dpp_ror<4>(v)); v = fmaxf(v, dpp_ror<2>(v)); v = fmaxf(v, dpp_ror<1>(v)); return v; }
#define SCAN_BAR() asm volatile("s_waitcnt lgkmcnt(0)\n\ts_barrier" ::: "memory")
__device__ __forceinline__ float lds_sum8_st64(const LAS float* p) {
    f32x2 a, b, c, d;
    const unsigned addr = (unsigned)(unsigned long long)p;
    asm volatile("ds_read2st64_b32 %0, %4 offset1:1\n\tds_read2st64_b32 %1, %4 offset0:2 offset1:3\n\tds_read2st64_b32 %2, %4 offset0:4 offset1:5\n\tds_read2st64_b32 %3, %4 offset0:6 offset1:7\n\ts_waitcnt lgkmcnt(0)"
                 : "=&v"(a), "=&v"(b), "=&v"(c), "=&v"(d) : "v"(addr) : "memory");
    return ((a.x + a.y) + (b.x + b.y)) + ((c.x + c.y) + (d.x + d.y));
}
__device__ __forceinline__ void rwkv_scan2(LAS unsigned char* lds, int bh, int w, int lane, const bf16* Zr, const bf16* LP, const unsigned char* REC, const float* BONUS, bf16* Y,
                                           const float* mu, const float* lng, const float* lnb) {
    const int b = bh / 6, h = bh % 6;
    const size_t m0 = (size_t)b * SEQ;
    const u32x4* rec = (const u32x4*)(REC + (size_t)bh * SEQ * REC_STEP + w * 16);
    const bf16* pv = Zr + m0 * ZR_P + 768 + h * 64 + lane;
    const bf16* pg = LP + m0 * LP_P + 1024 + h * 64 + lane;
    const float* pbon = BONUS + m0 * 6 + h;
    bf16* py = Y + m0 * Y_P + h * 64 + lane;
    const float muv = mu[768 + h * 64 + lane], lg = lng[h * 64 + lane], lb = lnb[h * 64 + lane];
    LAS float* ex = (LAS float*)lds;
    LAS float* ey = (LAS float*)(lds + 4096);
    float s[8];
#pragma unroll
    for (int i = 0; i < 8; ++i) s[i] = 0.f;
    constexpr int PD = 4;
    bf16 bv[PD];
#pragma unroll
    for (int j = 0; j < PD; ++j) bv[j] = pv[(size_t)j * ZR_P];
    bf16 gq = pg[(size_t)w * LP_P]; float bq = pbon[(size_t)w * 6];
    u32x4 raw[PD][5];
#pragma unroll
    for (int p = 0; p < PD; ++p)
#pragma unroll
        for (int j = 0; j < 5; ++j) raw[p][j] = rec[p * (REC_STEP / 16) + j * 8];
    float vprev = 0.f, vs_last = 0.f;
    for (int t0 = 0; t0 < SEQ; t0 += PD) {
#pragma unroll
        for (int jj = 0; jj < PD; ++jj) {
            const int t = t0 + jj;
            float rk[8], xk[8], kk[8], ak[8], bk[8];
#define UNPK(dst, q) { dst[0] = hlo(q.x); dst[1] = hhi(q.x); dst[2] = hlo(q.y); dst[3] = hhi(q.y); dst[4] = hlo(q.z); dst[5] = hhi(q.z); dst[6] = hlo(q.w); dst[7] = hhi(q.w); }
            UNPK(rk, raw[jj][0]) UNPK(xk, raw[jj][1]) UNPK(kk, raw[jj][2]) UNPK(ak, raw[jj][3]) UNPK(bk, raw[jj][4])
#undef UNPK
            { const int tn = (t + PD < SEQ) ? t + PD : SEQ - 1;
#pragma unroll
              for (int j = 0; j < 5; ++j) raw[jj][j] = rec[tn * (REC_STEP / 16) + j * 8]; }
            const float vr = bf2f(bv[jj]);
            { const int tn = (t + PD < SEQ) ? t + PD : SEQ - 1; bv[jj] = pv[(size_t)tn * ZR_P]; }
            const float vs = vr + (vprev - vr) * muv; vprev = vr;
            float sap = 0.f;
#pragma unroll
            for (int i = 0; i < 8; ++i) sap = __builtin_fmaf(s[i], ak[i], sap);
            ex[((t & 1) * 8 + w) * 64 + lane] = sap;
            SCAN_BAR();
            const float nsa = -lds_sum8_st64(ex + (t & 1) * 512 + lane);
            float yp = 0.f;
#pragma unroll
            for (int i = 0; i < 8; ++i) { float tt = __builtin_fmaf(-xk[i], s[i], s[i]); tt = __builtin_fmaf(nsa, bk[i], tt); tt = __builtin_fmaf(vs, kk[i], tt); s[i] = tt; yp = __builtin_fmaf(tt, rk[i], yp); }
            ey[((t & 1) * 8 + w) * 64 + lane] = yp;
            if (t > 0 && ((t - 1) & 7) == w) {
                const int tp = t - 1;
                const float y = lds_sum8_st64(ey + (tp & 1) * 512 + lane);
                const float mean = wave_allsum(y) * (1.f / 64.f);
                const float d = y - mean;
                const float var = wave_allsum(d * d) * (1.f / 64.f);
                const float o = (d * (1.f / sqrtf(var + 64e-5f)) * lg + lb + bq * vs_last) * bf2f(gq);
                py[(size_t)tp * Y_P] = (bf16)f2bf(o);
                const int tq = (tp + 8 < SEQ) ? tp + 8 : SEQ - 1;
                gq = pg[(size_t)tq * LP_P]; bq = pbon[(size_t)tq * 6];
            }
            vs_last = vs;
        }
    }
    SCAN_BAR();
    if (((SEQ - 1) & 7) == w) {
        const int tp = SEQ - 1;
        const float y = lds_sum8_st64(ey + (tp & 1) * 512 + lane);
        const float mean = wave_allsum(y) * (1.f / 64.f);
        const float d = y - mean;
        const float var = wave_allsum(d * d) * (1.f / 64.f);
        const float o = (d * (1.f / sqrtf(var + 64e-5f)) * lg + lb + bq * vs_last) * bf2f(gq);
        py[(size_t)tp * Y_P] = (bf16)f2bf(o);
    }
}

struct HalfBar { LAS unsigned* ctr; unsigned target; };
__device__ __forceinline__ void hbar(HalfBar& hb, int lt) {
    asm volatile("s_waitcnt lgkmcnt(0)" ::: "memory");
    if ((lt & 63) == 0) __hip_atomic_fetch_add(hb.ctr, 1u, __ATOMIC_RELAXED, __HIP_MEMORY_SCOPE_WORKGROUP);
    hb.target += 4u;
    while (__hip_atomic_load(hb.ctr, __ATOMIC_RELAXED, __HIP_MEMORY_SCOPE_WORKGROUP) < hb.target) __builtin_amdgcn_s_sleep(1);
    asm volatile("" ::: "memory");
}
#define MFMA16(a, b, c) __builtin_amdgcn_mfma_f32_16x16x32_bf16(a, b, c, 0, 0, 0)
constexpr int TS = 72;
__device__ __forceinline__ void retention_item(LAS unsigned char* base, HalfBar& hbr, int item, int lt, const bf16* Zt, bf16* Y, const float* gn_g, const float* gn_b,
                                               const float* ropec, const float* ropes, const float* gpow_all) {
    const int b = item / 6, h = item % 6;
    const int wv = lt >> 6, lane = lt & 63, fr = lane & 15, fq = lane >> 4;
    LAS bf16* Qs = (LAS bf16*)base; LAS bf16* Ks = (LAS bf16*)(base + 9216); LAS bf16* Kdt = (LAS bf16*)(base + 18432); LAS bf16* Vt = (LAS bf16*)(base + 27648);
    LAS bf16* Rt = (LAS bf16*)(base + 36864); LAS bf16* Ps = (LAS bf16*)(base + 46080 + wv * 2304); LAS float* gp = (LAS float*)(base + 55296);
    if (lt < 65) gp[lt] = gpow_all[h * 65 + lt];
    for (int i = lt; i < 64 * TS / 2; i += 256) ((LAS unsigned*)Rt)[i] = 0u;
    f32x4 R[4];
#pragma unroll
    for (int nt = 0; nt < 4; ++nt) R[nt] = (f32x4){0.f, 0.f, 0.f, 0.f};
    hbar(hbr, lt);
    const float cdec = gp[64];
    const int row = lt >> 2, qd = lt & 3;
    u32x4 rq1, rq2, rk1, rk2, rv0, rv1; f32x4 rc0, rc1, rs0, rs1; unsigned gq[16];
#define RET_LOAD(nn) { const size_t mm_ = (size_t)b * SEQ + (size_t)(nn) * 64; const bf16* zr_ = Zt + (mm_ + row) * ZT_P + h * 64; const int pos_ = (nn) * 64 + row; \
        rq1 = *(const u32x4*)(zr_ + 8 * qd); rq2 = *(const u32x4*)(zr_ + 32 + 8 * qd); rk1 = *(const u32x4*)(zr_ + 384 + 8 * qd); rk2 = *(const u32x4*)(zr_ + 384 + 32 + 8 * qd); \
        rv0 = *(const u32x4*)(zr_ + 768 + 16 * qd); rv1 = *(const u32x4*)(zr_ + 768 + 16 * qd + 8); \
        rc0 = *(const f32x4*)(ropec + pos_ * 32 + 8 * qd); rc1 = *(const f32x4*)(ropec + pos_ * 32 + 8 * qd + 4); rs0 = *(const f32x4*)(ropes + pos_ * 32 + 8 * qd); rs1 = *(const f32x4*)(ropes + pos_ * 32 + 8 * qd + 4); \
        _Pragma("unroll") for (int j_ = 0; j_ < 4; ++j_) _Pragma("unroll") for (int nt_ = 0; nt_ < 4; ++nt_) gq[j_ * 4 + nt_] = Zt[(mm_ + 16 * wv + 4 * fq + j_) * ZT_P + 1152 + h * 64 + 16 * nt_ + fr]; }
    RET_LOAD(0)
    for (int n = 0; n < 32; ++n) {
        const size_t m0 = (size_t)b * SEQ + n * 64;
        float gcur[16];
        {
            float c[8], s[8];
            c[0] = rc0.x; c[1] = rc0.y; c[2] = rc0.z; c[3] = rc0.w; c[4] = rc1.x; c[5] = rc1.y; c[6] = rc1.z; c[7] = rc1.w;
            s[0] = rs0.x; s[1] = rs0.y; s[2] = rs0.z; s[3] = rs0.w; s[4] = rs1.x; s[5] = rs1.y; s[6] = rs1.z; s[7] = rs1.w;
            float a1[8], a2[8], o1[8], o2[8];
            unpack8(rq1, a1); unpack8(rq2, a2);
#pragma unroll
            for (int i = 0; i < 8; ++i) { o1[i] = a1[i] * c[i] - a2[i] * s[i]; o2[i] = a1[i] * s[i] + a2[i] * c[i]; }
            *(LAS u32x4*)(Qs + row * TS + 8 * qd) = pack8(o1); *(LAS u32x4*)(Qs + row * TS + 32 + 8 * qd) = pack8(o2);
            unpack8(rk1, a1); unpack8(rk2, a2);
#pragma unroll
            for (int i = 0; i < 8; ++i) { o1[i] = (a1[i] * c[i] - a2[i] * s[i]) * 0.125f; o2[i] = (a1[i] * s[i] + a2[i] * c[i]) * 0.125f; }
            *(LAS u32x4*)(Ks + row * TS + 8 * qd) = pack8(o1); *(LAS u32x4*)(Ks + row * TS + 32 + 8 * qd) = pack8(o2);
            const float kd = gp[63 - row];
#pragma unroll
            for (int i = 0; i < 8; ++i) { Kdt[(8 * qd + i) * TS + row] = (bf16)f2bf(o1[i] * kd); Kdt[(32 + 8 * qd + i) * TS + row] = (bf16)f2bf(o2[i] * kd); }
            const unsigned vw[8] = {rv0.x, rv0.y, rv0.z, rv0.w, rv1.x, rv1.y, rv1.z, rv1.w};
#pragma unroll
            for (int i = 0; i < 8; ++i) { Vt[(16 * qd + 2 * i) * TS + row] = (bf16)(vw[i] & 0xffffu); Vt[(16 * qd + 2 * i + 1) * TS + row] = (bf16)(vw[i] >> 16); }
#pragma unroll
            for (int i = 0; i < 16; ++i) gcur[i] = bf2f(gq[i]);
            if (n + 1 < 32) RET_LOAD(n + 1)
        }
        hbar(hbr, lt);
        f32x4 y[4];
        {
            bf16x8 aq[2];
#pragma unroll
            for (int ks = 0; ks < 2; ++ks) aq[ks] = *(const LAS bf16x8*)(Qs + (16 * wv + fr) * TS + 32 * ks + 8 * fq);
#pragma unroll
            for (int nt = 0; nt < 4; ++nt) { f32x4 acc = (f32x4){0.f, 0.f, 0.f, 0.f};
#pragma unroll
                for (int ks = 0; ks < 2; ++ks) acc = MFMA16(aq[ks], *(const LAS bf16x8*)(Rt + (16 * nt + fr) * TS + 32 * ks + 8 * fq), acc);
#pragma unroll
                for (int j = 0; j < 4; ++j) acc[j] *= gp[16 * wv + 4 * fq + j + 1];
                y[nt] = acc; }
#pragma unroll
            for (int nt = 0; nt < 4; ++nt) { f32x4 acc = (f32x4){0.f, 0.f, 0.f, 0.f};
#pragma unroll
                for (int ks = 0; ks < 2; ++ks) acc = MFMA16(aq[ks], *(const LAS bf16x8*)(Ks + (16 * nt + fr) * TS + 32 * ks + 8 * fq), acc);
#pragma unroll
                for (int j = 0; j < 4; ++j) { const int i = 16 * wv + 4 * fq + j, jj = 16 * nt + fr; const int d = i > jj ? i - jj : jj - i;
                    Ps[(4 * fq + j) * TS + 16 * nt + fr] = (bf16)f2bf(acc[j] * gp[d]); } }
            LDS_WAIT();
            bf16x8 ap[2];
#pragma unroll
            for (int ks = 0; ks < 2; ++ks) ap[ks] = *(const LAS bf16x8*)(Ps + fr * TS + 32 * ks + 8 * fq);
            bf16x8 ak[2];
#pragma unroll
            for (int ks = 0; ks < 2; ++ks) ak[ks] = *(const LAS bf16x8*)(Kdt + (16 * wv + fr) * TS + 32 * ks + 8 * fq);
#pragma unroll
            for (int nt = 0; nt < 4; ++nt) { f32x4 rn = R[nt] * cdec;
#pragma unroll
                for (int ks = 0; ks < 2; ++ks) { const bf16x8 vb = *(const LAS bf16x8*)(Vt + (16 * nt + fr) * TS + 32 * ks + 8 * fq);
                    y[nt] = MFMA16(ap[ks], vb, y[nt]); rn = MFMA16(ak[ks], vb, rn); }
                R[nt] = rn; }
        }
        hbar(hbr, lt);
#pragma unroll
        for (int nt = 0; nt < 4; ++nt) { u32x2 w; w.x = pk2(R[nt][0], R[nt][1]); w.y = pk2(R[nt][2], R[nt][3]); *(LAS u32x2*)(Rt + (16 * nt + fr) * TS + 16 * wv + 4 * fq) = w; }
        float gg[4], gb[4];
#pragma unroll
        for (int nt = 0; nt < 4; ++nt) { gg[nt] = gn_g[h * 64 + 16 * nt + fr]; gb[nt] = gn_b[h * 64 + 16 * nt + fr]; }
#pragma unroll
        for (int j = 0; j < 4; ++j) {
            const float mean = row16_allsum((y[0][j] + y[1][j]) + (y[2][j] + y[3][j])) * (1.f / 64.f);
            float q = 0.f;
#pragma unroll
            for (int nt = 0; nt < 4; ++nt) { const float d = y[nt][j] - mean; q += d * d; }
            const float rstd = 1.f / sqrtf(row16_allsum(q) * (1.f / 64.f) + 1e-5f);
            const size_t m = m0 + 16 * wv + 4 * fq + j;
#pragma unroll
            for (int nt = 0; nt < 4; ++nt) { const int e = 16 * nt + fr;
                const float g = gcur[j * 4 + nt];
                const float o = ((y[nt][j] - mean) * rstd * gg[nt] + gb[nt]) * (g * sigmoidf_(g));
                Y[m * Y_P + 384 + h * 64 + e] = (bf16)f2bf(o); }
        }
    }
    hbar(hbr, lt);
}

#undef RET_LOAD
__device__ __forceinline__ void att_group(const LAS bf16* Qg, const LAS bf16* Ks, const LAS bf16* Vt, LAS bf16* Ps, const LAS float* bt, int dn, int wv, int fr, int fq,
                                          float (&mrun)[4], float (&lrun)[4], f32x4 (&O)[4]) {
    bf16x8 aq[2];
#pragma unroll
    for (int ks = 0; ks < 2; ++ks) aq[ks] = *(const LAS bf16x8*)(Qg + (16 * wv + fr) * TS + 32 * ks + 8 * fq);
    f32x4 sc[4];
#pragma unroll
    for (int nt = 0; nt < 4; ++nt) { f32x4 acc = (f32x4){0.f, 0.f, 0.f, 0.f};
#pragma unroll
        for (int ks = 0; ks < 2; ++ks) acc = MFMA16(aq[ks], *(const LAS bf16x8*)(Ks + (16 * nt + fr) * TS + 32 * ks + 8 * fq), acc);
        if (dn >= 3) {
            const float bfar = bt[191];
#pragma unroll
            for (int j = 0; j < 4; ++j) acc[j] += bfar;
        } else {
#pragma unroll
            for (int j = 0; j < 4; ++j) { int rel = 64 * dn + (16 * wv + 4 * fq + j) - (16 * nt + fr); rel = rel < -63 ? -63 : (rel > 128 ? 128 : rel); acc[j] += bt[rel + 63]; }
        }
        sc[nt] = acc; }
#pragma unroll
    for (int j = 0; j < 4; ++j) {
        const float mx = row16_allmax(fmaxf(fmaxf(sc[0][j], sc[1][j]), fmaxf(sc[2][j], sc[3][j])));
        const float mnew = fmaxf(mrun[j], mx), corr = __expf(mrun[j] - mnew);
        float ps = 0.f;
#pragma unroll
        for (int nt = 0; nt < 4; ++nt) { const float p = __expf(sc[nt][j] - mnew); ps += p; Ps[(4 * fq + j) * TS + 16 * nt + fr] = (bf16)f2bf(p); O[nt][j] *= corr; }
        lrun[j] = lrun[j] * corr + row16_allsum(ps); mrun[j] = mnew;
    }
    LDS_WAIT();
    bf16x8 ap[2];
#pragma unroll
    for (int ks = 0; ks < 2; ++ks) ap[ks] = *(const LAS bf16x8*)(Ps + fr * TS + 32 * ks + 8 * fq);
#pragma unroll
    for (int nt = 0; nt < 4; ++nt)
#pragma unroll
        for (int ks = 0; ks < 2; ++ks) O[nt] = MFMA16(ap[ks], *(const LAS bf16x8*)(Vt + (16 * nt + fr) * TS + 32 * ks + 8 * fq), O[nt]);
    LDS_WAIT();
}
__device__ __forceinline__ void attention_item(LAS unsigned char* base, HalfBar& hbr, int item, int lt, const bf16* Za, bf16* Y, const float* rel_bias) {
    const int np = 15 - item / 128, rest = item % 128, b = rest >> 2, h = rest & 3, n0 = 2 * np, n1 = n0 + 1;
    const int wv = lt >> 6, lane = lt & 63, fr = lane & 15, fq = lane >> 4;
    LAS bf16* QsA = (LAS bf16*)base; LAS bf16* QsB = (LAS bf16*)(base + 9216); LAS bf16* Ks = (LAS bf16*)(base + 18432); LAS bf16* Vt = (LAS bf16*)(base + 27648);
    LAS bf16* Ps = (LAS bf16*)(base + 36864 + wv * 2304); LAS float* bt = (LAS float*)(base + 46080);
    const int row = lt >> 2, qd = lt & 3;
    if (lt < 192) bt[lt] = rel_bias[h * 192 + lt];
    { const bf16* qrow = Za + ((size_t)b * SEQ + n0 * 64 + row) * ZA_P + h * 64 + 16 * qd;
      *(LAS u32x4*)(QsA + row * TS + 16 * qd) = *(const u32x4*)qrow; *(LAS u32x4*)(QsA + row * TS + 16 * qd + 8) = *(const u32x4*)(qrow + 8);
      const bf16* qrow1 = qrow + (size_t)64 * ZA_P;
      *(LAS u32x4*)(QsB + row * TS + 16 * qd) = *(const u32x4*)qrow1; *(LAS u32x4*)(QsB + row * TS + 16 * qd + 8) = *(const u32x4*)(qrow1 + 8); }
    float mA[4], lA[4], mB[4], lB[4]; f32x4 OA[4], OB[4];
#pragma unroll
    for (int j = 0; j < 4; ++j) { mA[j] = -1e30f; lA[j] = 0.f; mB[j] = -1e30f; lB[j] = 0.f; }
#pragma unroll
    for (int nt = 0; nt < 4; ++nt) { OA[nt] = (f32x4){0.f, 0.f, 0.f, 0.f}; OB[nt] = (f32x4){0.f, 0.f, 0.f, 0.f}; }
    const int kc0 = n0 > 8 ? n0 - 8 : 0;
    const bf16* kbase = Za + ((size_t)b * SEQ + row) * ZA_P + 256 + h * 64 + 16 * qd;
    u32x4 k0, k1, v0, v1;
    { const bf16* krow = kbase + (size_t)kc0 * 64 * ZA_P; k0 = *(const u32x4*)krow; k1 = *(const u32x4*)(krow + 8); v0 = *(const u32x4*)(krow + 256); v1 = *(const u32x4*)(krow + 256 + 8); }
    for (int kc = kc0; kc <= n1; ++kc) {
        hbar(hbr, lt);
        { *(LAS u32x4*)(Ks + row * TS + 16 * qd) = k0; *(LAS u32x4*)(Ks + row * TS + 16 * qd + 8) = k1;
          const unsigned vw[8] = {v0.x, v0.y, v0.z, v0.w, v1.x, v1.y, v1.z, v1.w};
#pragma unroll
          for (int i = 0; i < 8; ++i) { Vt[(16 * qd + 2 * i) * TS + row] = (bf16)(vw[i] & 0xffffu); Vt[(16 * qd + 2 * i + 1) * TS + row] = (bf16)(vw[i] >> 16); } }
        if (kc < n1) { const bf16* krow = kbase + (size_t)(kc + 1) * 64 * ZA_P; k0 = *(const u32x4*)krow; k1 = *(const u32x4*)(krow + 8); v0 = *(const u32x4*)(krow + 256); v1 = *(const u32x4*)(krow + 256 + 8); }
        hbar(hbr, lt);
        if (kc <= n0 && kc + 8 >= n0) att_group(QsA, Ks, Vt, Ps, bt, n0 - kc, wv, fr, fq, mA, lA, OA);
        if (kc + 8 >= n1) att_group(QsB, Ks, Vt, Ps, bt, n1 - kc, wv, fr, fq, mB, lB, OB);
    }
#pragma unroll
    for (int j = 0; j < 4; ++j) { const float ia = 1.f / lA[j], ib = 1.f / lB[j]; const size_t m = (size_t)b * SEQ + n0 * 64 + 16 * wv + 4 * fq + j;
#pragma unroll
        for (int nt = 0; nt < 4; ++nt) { Y[m * Y_P + 768 + h * 64 + 16 * nt + fr] = (bf16)f2bf(OA[nt][j] * ia); Y[(m + 64) * Y_P + 768 + h * 64 + 16 * nt + fr] = (bf16)f2bf(OB[nt][j] * ib); } }
    hbar(hbr, lt);
}

#define XB_TMO      128
#define XB_XCNT(j)  (256  + 64 * (j))
#define XB_XSUB(j)  (1280 + 64 * (j))
#define XB_XGEN(j)  (2304 + 64 * (j))
#define XB_TOP      3328
#define XB_TOPGEN   3392
#define XCD_BAR_WORDS 3456
#define XB_SPIN_CAP (1u << 18)
__device__ __forceinline__ unsigned xb_ld(unsigned* p)              { return __hip_atomic_load(p, __ATOMIC_RELAXED, __HIP_MEMORY_SCOPE_AGENT); }
__device__ __forceinline__ unsigned xb_add(unsigned* p, unsigned v) { return __hip_atomic_fetch_add(p, v, __ATOMIC_RELAXED, __HIP_MEMORY_SCOPE_AGENT); }
__device__ __forceinline__ unsigned xb_xcc_id() { return (unsigned)__builtin_amdgcn_s_getreg((3 << 11) | 20) & 0xFu; }
#define XB_SPIN(cond, bar) do { unsigned _sp = 0; while (cond) { __builtin_amdgcn_s_sleep(1); \
    if ((++_sp & 255u) == 0u) { if (xb_ld(&(bar)[XB_TMO])) break; if (_sp > XB_SPIN_CAP) { atomicAdd(&(bar)[XB_TMO], 1u); break; } } } } while (0)
__device__ __forceinline__ void xcd_barrier_complete(unsigned* bar, unsigned x, unsigned& nloc, unsigned& nx) {
    const unsigned G = gridDim.x * gridDim.y * gridDim.z;
    unsigned sum, cnt, mine, sp = 0u;
    for (;;) {
        sum = 0u; cnt = 0u; mine = 0u;
#pragma unroll
        for (unsigned j = 0; j < 16; ++j) { const unsigned c = xb_ld(&bar[XB_XCNT(j)]); sum += c; cnt += (c > 0u) ? 1u : 0u; mine = (j == x) ? c : mine; }
        if (sum == G) break;
        __builtin_amdgcn_s_sleep(1);
        if ((++sp & 255u) == 0u) { if (xb_ld(&bar[XB_TMO])) break; if (sp > XB_SPIN_CAP) { atomicAdd(&bar[XB_TMO], 1u); break; } }
    }
    nloc = mine > 0u ? mine : 1u; nx = cnt > 0u ? cnt : 1u;
}
__device__ __forceinline__ void xcd_barrier(unsigned* bar, volatile LAS unsigned* st, int tid) {
    asm volatile("s_waitcnt vmcnt(0)" ::: "memory");
    __syncthreads();
    if (tid == 0) {
        const unsigned x = xb_xcc_id();
        __builtin_amdgcn_s_waitcnt(0);
        unsigned nloc = st[0], nx = st[1];
        if (nloc == 0u) { xcd_barrier_complete(bar, x, nloc, nx); st[0] = nloc; st[1] = nx; }
        const unsigned old = xb_add(&bar[XB_XSUB(x)], 1u);
        const unsigned gen = old / nloc;
        if (old + 1u == (gen + 1u) * nloc) {
            __builtin_amdgcn_fence(__ATOMIC_RELEASE, "agent");
            asm volatile("s_waitcnt vmcnt(0)" ::: "memory");
            const unsigned og = xb_add(&bar[XB_TOP], 1u);
            const unsigned tg = og / nx;
            if (og + 1u == (tg + 1u) * nx) xb_add(&bar[XB_TOPGEN], 1u);
            else XB_SPIN(xb_ld(&bar[XB_TOPGEN]) == tg, bar);
            __builtin_amdgcn_fence(__ATOMIC_ACQUIRE, "agent");
            xb_add(&bar[XB_XGEN(x)], 1u);
            asm volatile("s_waitcnt vmcnt(0)" ::: "memory");
        } else {
            XB_SPIN(xb_ld(&bar[XB_XGEN(x)]) == gen, bar);
            __builtin_amdgcn_fence(__ATOMIC_ACQUIRE, "agent");
            asm volatile("s_waitcnt vmcnt(0)" ::: "memory");
        }
    }
    __syncthreads();
}
constexpr size_t WS_BAR = 65536;
constexpr size_t WS_PCNT = 131072;
constexpr size_t WS_XBUF = 56 * MiB;
struct Args { const float* in[27]; float* out; unsigned char* ws; };
constexpr int N_RET_ITEMS = 192, N_ATT_ITEMS = 2048, N_SCAN_BLOCKS = 192;

#define PHASE_LOCALS \
    unsigned ones_ = ~0u; asm volatile("" : "+s"(ones_)); \
    int tid = wave_id * 64 + (int)__builtin_amdgcn_mbcnt_hi(ones_, __builtin_amdgcn_mbcnt_lo(ones_, 0u)); asm volatile("" : "+v"(tid)); \
    const int lane = tid & 63, wave = wave_id; \
    const __attribute__((address_space(4))) unsigned char* kp = (const __attribute__((address_space(4))) unsigned char*)__builtin_amdgcn_kernarg_segment_ptr(); asm volatile("" : "+s"(kp)); \
    unsigned char* ws = (unsigned char*)KARG(224); \
    const int G = gridDim.x, bx = blockIdx.x; \
    const int gw = bx * 8 + wave, NGW = G * 8, gt = bx * 512 + tid, NGT = G * 512; \
    (void)lane; (void)gw; (void)NGW; (void)gt; (void)NGT; (void)ws;
#define IN(i) KARG(8 * (i))
#define XPTR ((float*)KARG(216))


#ifndef PROBE_M1
#define PROBE_M1 0ull
#endif
#ifndef PROBE_M2
#define PROBE_M2 0ull
#endif
#ifndef PROBE_XSYNC
#define PROBE_XSYNC 0
#endif
#define PROBE_ON ((PROBE_M1 | PROBE_M2) != 0ull)
#define STAMP(k) do { if (PROBE_ON && blockIdx.x == 0 && threadIdx.x == 0) ((volatile LAS unsigned long long*)(lds + MISC_OFF + 64))[k] = __builtin_amdgcn_s_memrealtime(); } while (0)
#define GRID_BAR() do { unsigned ob_ = ~0u; asm volatile("" : "+s"(ob_)); \
    const int tb_ = wave_id * 64 + (int)__builtin_amdgcn_mbcnt_hi(ob_, __builtin_amdgcn_mbcnt_lo(ob_, 0u)); \
    const __attribute__((address_space(4))) unsigned char* kp = (const __attribute__((address_space(4))) unsigned char*)__builtin_amdgcn_kernarg_segment_ptr(); asm volatile("" : "+s"(kp)); \
    xcd_barrier((unsigned*)((unsigned char*)KARG(224) + WS_BAR), (volatile LAS unsigned*)(lds + MISC_OFF + 32), tb_); } while (0)
__global__ void __launch_bounds__(512, 2) fwd_megakernel(Args a) {
    extern __shared__ __attribute__((aligned(16))) unsigned char lds_raw[];
    LAS unsigned char* lds = (LAS unsigned char*)lds_raw;
    cg::grid_group grid = cg::this_grid();
    const int wave_id = __builtin_amdgcn_readfirstlane(threadIdx.x >> 6);
    STAMP(0);
    int stamp_id = 1;
#define NEXT_STAMP() do { STAMP(stamp_id); ++stamp_id; } while (0)

    {
        PHASE_LOCALS
        unsigned* ctl = (unsigned*)(ws + WS_CTL);
        float* ropec = (float*)(ws + WS_ROPEC); float* ropes = (float*)(ws + WS_ROPES); float* gpow = (float*)(ws + WS_GPOW);
        if (bx == 0 && tid < 16) ctl[tid] = 0u;
        if (bx == 0) for (int i = tid; i < XCD_BAR_WORDS; i += 512) ((unsigned*)(ws + WS_BAR))[i] = 0u;
        for (int i = gt; i < 65536; i += NGT) ((unsigned*)(ws + WS_PCNT))[i] = 0u;
        if (tid < 2) ((volatile LAS unsigned*)(lds + MISC_OFF + 32))[tid] = 0u;
        LAS float* scr = (LAS float*)(lds + wave * 16384);
        constexpr int I_IN = 16 * (NIN / 32), I_OUT = 16 * 32, I_UP = 16 * (DFF2 / 32), I_DN = (DFF / 64) * 32, I_L = I_IN + I_OUT + I_UP + I_DN;
        for (int it = gw; it < 2 * I_L; it += NGW) {
            const int l = it / I_L; int r = it % I_L;
            unsigned char* wl = ws + WS_W + (size_t)l * W_LAYER;
            if (r < I_IN) { p0_transpose_item(IN(3) + (size_t)l * DM * NIN, DM, NIN, (bf16*)(wl + WO_IN), 1, scr, r, lane); continue; } r -= I_IN;
            if (r < I_OUT) { p0_transpose_item(IN(18) + (size_t)l * DM * DM, DM, DM, (bf16*)(wl + WO_OUT), 0, scr, r, lane); continue; } r -= I_OUT;
            if (r < I_UP) { p0_transpose_item(IN(21) + (size_t)l * DM * DFF2, DM, DFF2, (bf16*)(wl + WO_UP), 2, scr, r, lane); continue; } r -= I_UP;
            p0_transpose_item(IN(24) + (size_t)l * DFF * DM, DFF, DM, (bf16*)(wl + WO_DN), 0, scr, r, lane);
        }
        for (int i = gt; i < 2 * 128 * DM / 8; i += NGT) {
            const int l = i / (128 * DM / 8), r = i % (128 * DM / 8);
            *((u32x4*)(ws + WS_W + (size_t)l * W_LAYER + WO_IN + (size_t)1408 * DM * 2) + r) = (u32x4){0u, 0u, 0u, 0u};
        }
        for (int i = gt; i < 2 * NLORA * KLORA; i += NGT) {
            const int l = i / (NLORA * KLORA), r = i % (NLORA * KLORA), n = r / KLORA, k = r % KLORA;
            float v = 0.f;
            if (n < 384) { if (k < 64) v = IN(6)[(size_t)l * 64 * 384 + k * 384 + n]; }
            else if (n < 768) { if (k >= 64 && k < 128) v = IN(8)[(size_t)l * 64 * 384 + (k - 64) * 384 + (n - 384)]; }
            else if (n < 1152) { if (k >= 128) v = IN(9)[(size_t)l * 128 * 384 + (k - 128) * 384 + (n - 768)]; }
            ((bf16*)(ws + WS_W + (size_t)l * W_LAYER + WO_LORA))[r] = (bf16)f2bf(v);
        }
        for (int i = gt; i < SEQ * 32; i += NGT) {
            const int t = i >> 5, ii = i & 31;
            const float inv = (float)exp2(-(double)ii * (13.287712379549449 / 32.0));
            const float ang = (float)t * inv;
            const double rev = (double)ang * 0.15915494309189535; const float fr_ = (float)(rev - floor(rev));
            ropec[i] = __builtin_amdgcn_cosf(fr_); ropes[i] = __builtin_amdgcn_sinf(fr_);
        }
        if (gt < 6) { const double g = 1.0 - exp2(-5.0 - (double)gt); double p = 1.0; for (int nn = 0; nn <= 64; ++nn) { gpow[gt * 65 + nn] = (float)p; p *= g; } }
        float* X = XPTR; bf16* XN = (bf16*)(ws + WS_XN);
        { Rows2f cur = ln_load2f(IN(0) + (size_t)(2 * gw) * DM, IN(0) + (size_t)(2 * gw + 1) * DM, lane);
          for (int m = 2 * gw; m < MTOK; m += 2 * NGW) {
              const int mn = (m + 2 * NGW < MTOK) ? m + 2 * NGW : m;
              const Rows2f nxt = ln_load2f(IN(0) + (size_t)mn * DM, IN(0) + (size_t)(mn + 1) * DM, lane);
              ln_row2(cur, IN(1), IN(2), (float*)nullptr, (float*)nullptr, XN + (size_t)m * DM, XN + (size_t)(m + 1) * DM, lane);
              cur = nxt; } }
    }
    grid.sync(); NEXT_STAMP();
    { PHASE_LOCALS
      if (tid == 0) (void)xb_add((unsigned*)(ws + WS_BAR) + XB_XCNT(xb_xcc_id()), 1u); }
    if (PROBE_XSYNC) { for (int i = 0; i < PROBE_XSYNC; ++i) grid.sync(); STAMP(40); }

    for (int l = 0; l < 2; ++l) {
        { PHASE_LOCALS
          pg8::Gemm g{(const bf16*)(ws + WS_XN), (const bf16*)(ws + WS_W + (size_t)l * W_LAYER + WO_IN), MTOK, NIN_PAD, DM, DM}; pg8::StaticOrder S; S.init(MTOK, NIN_PAD, G, bx);
          pg8::EpiZ E{(bf16*)(ws + WS_ZR), (bf16*)(ws + WS_ZT), (bf16*)(ws + WS_ZA)}; pg8::gemm_phase<pg8::EpiZ>(lds, g, S, E, wave_id); }
        GRID_BAR(); NEXT_STAMP();
        { PHASE_LOCALS
          const bf16* Zr = (const bf16*)(ws + WS_ZR); bf16* LP = (bf16*)(ws + WS_LP); const float* mu = IN(4) + l * 1408;
          for (int i = gt; i < MTOK * 32; i += NGT) {
            const int m = i >> 5, c8 = i & 31;
            float cur[8], prv[8], o[8];
            unpack8(*(const u32x4*)(Zr + (size_t)m * ZR_P + 1152 + 8 * c8), cur);
            if ((m & (SEQ - 1)) != 0) unpack8(*(const u32x4*)(Zr + (size_t)(m - 1) * ZR_P + 1152 + 8 * c8), prv);
            else {
#pragma unroll
                for (int j = 0; j < 8; ++j) prv[j] = 0.f; }
#pragma unroll
            for (int j = 0; j < 8; ++j) { const float sft = cur[j] + (prv[j] - cur[j]) * mu[1152 + 8 * c8 + j];
                const float sg = sigmoidf_(c8 < 8 ? 2.f * sft : sft);
                o[j] = c8 < 8 ? (2.f * sg - 1.f) : (c8 < 16 ? sft : sg); }
            *(u32x4*)(LP + (size_t)m * LP_P + 8 * c8) = pack8(o);
          } }
        GRID_BAR(); NEXT_STAMP();
        { PHASE_LOCALS
          bf16* LP = (bf16*)(ws + WS_LP);
          pg8::Gemm g{LP, (const bf16*)(ws + WS_W + (size_t)l * W_LAYER + WO_LORA), MTOK, NLORA, KLORA, LP_P}; pg8::StaticOrder S; S.init(MTOK, NLORA, G, bx);
          pg8::EpiBf16 E{LP + 256, LP_P}; pg8::gemm_phase<pg8::EpiBf16>(lds, g, S, E, wave_id); }
        GRID_BAR(); NEXT_STAMP();
        { PHASE_LOCALS
            const bf16* Zr = (const bf16*)(ws + WS_ZR); const bf16* LP = (const bf16*)(ws + WS_LP); bf16* REC = (bf16*)XPTR; float* BONUS = (float*)(ws + WS_BONUS);
            const float* mu = IN(4) + l * 1408;
            const float* w0 = IN(5) + l * 384; const float* a0 = IN(7) + l * 384; const float* k_k = IN(10) + l * 384; const float* k_a = IN(11) + l * 384; const float* r_k = IN(12) + l * 384;
            const int ts = lane >> 4, c4 = lane & 15;
            for (int it = gw; it < MTOK / 4; it += NGW) {
                const int m = it * 4 + ts, t = m & (SEQ - 1), bb = m >> 11;
                const bool hasprev = t != 0;
                const bf16* z = Zr + (size_t)m * ZR_P; const bf16* zp = z - ZR_P; const bf16* lp = LP + (size_t)m * LP_P;
#pragma unroll
                for (int h = 0; h < 6; ++h) {
                    const int c = h * 64 + 4 * c4;
                    const u32x2 kw = *(const u32x2*)(z + 384 + c), rw = *(const u32x2*)(z + c);
                    u32x2 kpw = (u32x2){0u, 0u}, rpw = (u32x2){0u, 0u};
                    if (hasprev) { kpw = *(const u32x2*)(zp + 384 + c); rpw = *(const u32x2*)(zp + c); }
                    const u32x2 wpw = *(const u32x2*)(lp + 256 + c), apw = *(const u32x2*)(lp + 640 + c);
                    const f32x4 muk = *(const f32x4*)(mu + 384 + c), mur = *(const f32x4*)(mu + c), w0v = *(const f32x4*)(w0 + c), a0v = *(const f32x4*)(a0 + c),
                                kkv = *(const f32x4*)(k_k + c), kav = *(const f32x4*)(k_a + c), rkv = *(const f32x4*)(r_k + c);
                    const float kf[4] = {bflo(kw.x), bfhi(kw.x), bflo(kw.y), bfhi(kw.y)}, rf[4] = {bflo(rw.x), bfhi(rw.x), bflo(rw.y), bfhi(rw.y)};
                    const float kpf[4] = {bflo(kpw.x), bfhi(kpw.x), bflo(kpw.y), bfhi(kpw.y)}, rpf[4] = {bflo(rpw.x), bfhi(rpw.x), bflo(rpw.y), bfhi(rpw.y)};
                    const float wf[4] = {bflo(wpw.x), bfhi(wpw.x), bflo(wpw.y), bfhi(wpw.y)}, af[4] = {bflo(apw.x), bfhi(apw.x), bflo(apw.y), bfhi(apw.y)};
                    float rs[4], xd[4], kpr[4], kkr[4], avv[4]; float n2 = 0.f, bon = 0.f;
#pragma unroll
                    for (int j = 0; j < 4; ++j) {
                        const float ks = kf[j] + (kpf[j] - kf[j]) * muk[j]; rs[j] = rf[j] + (rpf[j] - rf[j]) * mur[j];
                        const float av = sigmoidf_(a0v[j] + af[j]); avv[j] = av;
                        const float xx = -(w0v[j] + wf[j]);
                        const float sp = fmaxf(xx, 0.f) + __logf(1.f + __expf(-fabsf(xx)));
                        const float ew = __expf(-sp - 0.5f);
                        xd[j] = 1.f - __expf(-ew);
                        const float kk = ks * kkv[j]; kkr[j] = kk; n2 += kk * kk;
                        kpr[j] = ks * (1.f + (av - 1.f) * kav[j]);
                        bon += rs[j] * kpr[j] * rkv[j];
                    }
                    n2 = row16_allsum(n2); bon = row16_allsum(bon);
                    const float inv = 1.f / fmaxf(sqrtf(n2), 1e-12f);
                    bf16* rec = REC + (((size_t)(bb * 6 + h) * SEQ + t) * 5) * 64 + 4 * c4;
                    u32x2 o;
                    o.x = pkh2(rs[0], rs[1]); o.y = pkh2(rs[2], rs[3]); __builtin_nontemporal_store(o, (u32x2*)(rec));
                    o.x = pkh2(xd[0], xd[1]); o.y = pkh2(xd[2], xd[3]); __builtin_nontemporal_store(o, (u32x2*)(rec + 64));
                    o.x = pkh2(kpr[0], kpr[1]); o.y = pkh2(kpr[2], kpr[3]); __builtin_nontemporal_store(o, (u32x2*)(rec + 128));
                    o.x = pkh2(kkr[0] * inv, kkr[1] * inv); o.y = pkh2(kkr[2] * inv, kkr[3] * inv); __builtin_nontemporal_store(o, (u32x2*)(rec + 192));
                    o.x = pkh2(kkr[0] * inv * avv[0], kkr[1] * inv * avv[1]); o.y = pkh2(kkr[2] * inv * avv[2], kkr[3] * inv * avv[3]); __builtin_nontemporal_store(o, (u32x2*)(rec + 256));
                    if (c4 == 0) BONUS[(size_t)m * 6 + h] = bon;
                }
            }
        }
        GRID_BAR(); NEXT_STAMP();
        { PHASE_LOCALS
            bf16* Yb = (bf16*)(ws + WS_Y);
            const int hbi = tid >> 8, lt = tid & 255;
            volatile LAS int* sh_item = (volatile LAS int*)(lds + MISC_OFF) + hbi;
            if (tid < 2) ((LAS unsigned*)(lds + MISC_OFF + 16))[tid] = 0u;
            __syncthreads();
            HalfBar hbr{(LAS unsigned*)(lds + MISC_OFF + 16) + hbi, 0u};
            if (bx < N_SCAN_BLOCKS && hbi == 0) { rwkv_scan(bx, wave, lane, (const bf16*)(ws + WS_ZR), (const unsigned char*)XPTR, Yb, IN(4) + l * 1408); STAMP(41 + l); }
            LAS unsigned char* hbase = lds + hbi * 57344;
            bool ret_open = !(bx < N_SCAN_BLOCKS && hbi == 1);
            unsigned* qret = (unsigned*)(ws + WS_CTL) + 2 * l; unsigned* qatt = qret + 1;
            for (;;) {
                if (lt == 0) {
                    int it = -1;
                    if (ret_open) { it = (int)atomicAdd(qret, 1u); if (it >= N_RET_ITEMS) it = -1; }
                    if (it < 0) { const int a2 = (int)atomicAdd(qatt, 1u); it = (a2 < N_ATT_ITEMS) ? N_RET_ITEMS + a2 : -2; }
                    *sh_item = it;
                }
                hbar(hbr, lt);
                const int item = *sh_item;
                hbar(hbr, lt);
                if (item < 0) break;
                if (item < N_RET_ITEMS) retention_item(hbase, hbr, item, lt, (const bf16*)(ws + WS_ZT), Yb, IN(15) + l * 384, IN(16) + l * 384, (const float*)(ws + WS_ROPEC), (const float*)(ws + WS_ROPES), (const float*)(ws + WS_GPOW));
                else { ret_open = false; attention_item(hbase, hbr, item - N_RET_ITEMS, lt, (const bf16*)(ws + WS_ZA), Yb, IN(17) + l * 4 * 192); }
            }
        }
        GRID_BAR(); NEXT_STAMP();
        { PHASE_LOCALS
            const bf16* Zr = (const bf16*)(ws + WS_ZR); const bf16* LP = (const bf16*)(ws + WS_LP); bf16* Yb = (bf16*)(ws + WS_Y); const float* BONUS = (const float*)(ws + WS_BONUS);
            const float* mu = IN(4) + l * 1408; const float* lng = IN(13) + l * 384; const float* lnb = IN(14) + l * 384;
            const int ts = lane >> 4, c4 = lane & 15;
            for (int it = gw; it < MTOK / 4; it += NGW) {
                const int m = it * 4 + ts;
                const bool hasprev = (m & (SEQ - 1)) != 0;
                const bf16* z = Zr + (size_t)m * ZR_P; const bf16* zp = z - ZR_P; const bf16* lp = LP + (size_t)m * LP_P; bf16* yr = Yb + (size_t)m * Y_P;
#pragma unroll
                for (int h = 0; h < 6; ++h) {
                    const int c = h * 64 + 4 * c4;
                    const u32x2 yw = *(const u32x2*)(yr + c), vw = *(const u32x2*)(z + 768 + c), gw_ = *(const u32x2*)(lp + 1024 + c);
                    u32x2 vpw = (u32x2){0u, 0u}; if (hasprev) vpw = *(const u32x2*)(zp + 768 + c);
                    const f32x4 muv = *(const f32x4*)(mu + 768 + c), lgv = *(const f32x4*)(lng + c), lbv = *(const f32x4*)(lnb + c);
                    const float bon = BONUS[(size_t)m * 6 + h];
                    const float yf[4] = {bflo(yw.x), bfhi(yw.x), bflo(yw.y), bfhi(yw.y)}, vf[4] = {bflo(vw.x), bfhi(vw.x), bflo(vw.y), bfhi(vw.y)};
                    const float vpf[4] = {bflo(vpw.x), bfhi(vpw.x), bflo(vpw.y), bfhi(vpw.y)}, gf[4] = {bflo(gw_.x), bfhi(gw_.x), bflo(gw_.y), bfhi(gw_.y)};
                    const float mean = row16_allsum((yf[0] + yf[1]) + (yf[2] + yf[3])) * (1.f / 64.f);
                    float q = 0.f;
#pragma unroll
                    for (int j = 0; j < 4; ++j) { const float d = yf[j] - mean; q += d * d; }
                    const float rstd = 1.f / sqrtf(row16_allsum(q) * (1.f / 64.f) + 64e-5f);
                    float o[4];
#pragma unroll
                    for (int j = 0; j < 4; ++j) { const float vs = vf[j] + (vpf[j] - vf[j]) * muv[j]; o[j] = ((yf[j] - mean) * rstd * lgv[j] + lbv[j] + bon * vs) * gf[j]; }
                    u32x2 ow; ow.x = pk2(o[0], o[1]); ow.y = pk2(o[2], o[3]); *(u32x2*)(yr + c) = ow;
                }
            }
        }
        GRID_BAR(); NEXT_STAMP();
        for (int rnd = 0; rnd < 4; ++rnd) { PHASE_LOCALS
          pg8::Gemm g{(const bf16*)(ws + WS_Y), (const bf16*)(ws + WS_W + (size_t)l * W_LAYER + WO_OUT), MTOK, DM, DM, DM}; pg8::StaticOrder S; S.init(MTOK, DM, G, bx); S.i0 = rnd; S.ni = 1;
          pg8::PanelStats st{(unsigned long long*)(ws + WS_XBUF + (size_t)(2 * l) * 2 * MiB), (unsigned*)(ws + WS_PCNT + (size_t)(2 * l) * 65536), LN_EPS};
          pg8::EpiLnFused E{(bf16*)(ws + WS_XN), (float*)nullptr, true, IN(19) + l * DM, IN(20) + l * DM, ALPHA, st};
          pg8::gemm_phase<pg8::EpiLnFused>(lds, g, S, E, wave_id); }
        GRID_BAR(); NEXT_STAMP();
        { PHASE_LOCALS
          pg8::Gemm g{(const bf16*)(ws + WS_XN), (const bf16*)(ws + WS_W + (size_t)l * W_LAYER + WO_UP), MTOK, DFF2, DM, DM}; pg8::StaticOrder S; S.init(MTOK, DFF2, G, bx);
          pg8::EpiConvGate E{kp, l, lds + 132096}; pg8::gemm_phase<pg8::EpiConvGate>(lds, g, S, E, wave_id); }
        GRID_BAR(); NEXT_STAMP();
        { PHASE_LOCALS
          const bf16* UB = (const bf16*)(ws + WS_UB); bf16* HH = (bf16*)(ws + WS_HH);
          const float* cw = IN(22) + (size_t)l * 3 * DFF2; const float* cb = IN(23) + (size_t)l * DFF2;
          for (int i = gt; i < (MTOK / 64) * 2 * (DFF / 4); i += NGT) {
              const int j = 4 * (i % (DFF / 4)), q = i / (DFF / 4), rr = q & 1, blk = q >> 1;
              const bool first = (blk & 31) == 0;
              const bf16* u0p = UB + ((size_t)(blk * 4 + rr) * 2) * DFF + j;
              const bf16* u1p = rr == 1 ? UB + ((size_t)(blk * 4 + 0) * 2) * DFF + j : UB + ((size_t)((blk - 1) * 4 + 3) * 2) * DFF + j;
              const bf16* u2p = rr == 1 ? UB + ((size_t)((blk - 1) * 4 + 3) * 2) * DFF + j : UB + ((size_t)((blk - 1) * 4 + 2) * 2) * DFF + j;
              const u32x2 g0w = *(const u32x2*)u0p, v0w = *(const u32x2*)(u0p + DFF);
              u32x2 g1w = (u32x2){0u, 0u}, v1w = g1w, g2w = g1w, v2w = g1w;
              if (rr == 1 || !first) { g1w = *(const u32x2*)u1p; v1w = *(const u32x2*)(u1p + DFF); }
              if (!first) { g2w = *(const u32x2*)u2p; v2w = *(const u32x2*)(u2p + DFF); }
              const float g0[4] = {bflo(g0w.x), bfhi(g0w.x), bflo(g0w.y), bfhi(g0w.y)}, v0[4] = {bflo(v0w.x), bfhi(v0w.x), bflo(v0w.y), bfhi(v0w.y)};
              const float g1[4] = {bflo(g1w.x), bfhi(g1w.x), bflo(g1w.y), bfhi(g1w.y)}, v1[4] = {bflo(v1w.x), bfhi(v1w.x), bflo(v1w.y), bfhi(v1w.y)};
              const float g2[4] = {bflo(g2w.x), bfhi(g2w.x), bflo(g2w.y), bfhi(g2w.y)}, v2[4] = {bflo(v2w.x), bfhi(v2w.x), bflo(v2w.y), bfhi(v2w.y)};
              float h[4];
              const f32x4 pbg = *(const f32x4*)(cb + j), pg0 = *(const f32x4*)(cw + j), pg1 = *(const f32x4*)(cw + DFF2 + j), pg2 = *(const f32x4*)(cw + 2 * DFF2 + j);
              const f32x4 pbv = *(const f32x4*)(cb + DFF + j), pv0 = *(const f32x4*)(cw + DFF + j), pv1 = *(const f32x4*)(cw + DFF2 + DFF + j), pv2 = *(const f32x4*)(cw + 2 * DFF2 + DFF + j);
#pragma unroll
              for (int k = 0; k < 4; ++k) {
                  const float cg = pbg[k] + pg0[k] * g2[k] + pg1[k] * g1[k] + pg2[k] * g0[k];
                  const float cv = pbv[k] + pv0[k] * v2[k] + pv1[k] * v1[k] + pv2[k] * v0[k];
                  h[k] = cg * cv * __builtin_amdgcn_rcpf(1.f + __expf(-cg));
              }
              u32x2 w; w.x = pk2(h[0], h[1]); w.y = pk2(h[2], h[3]); *(u32x2*)(HH + ((size_t)blk * 64 + rr) * DFF + j) = w;
          } }
        GRID_BAR(); NEXT_STAMP();
        for (int rnd = 0; rnd < 4; ++rnd) { PHASE_LOCALS
          pg8::Gemm g{(const bf16*)(ws + WS_HH), (const bf16*)(ws + WS_W + (size_t)l * W_LAYER + WO_DN), MTOK, DM, DFF, DFF}; pg8::StaticOrder S; S.init(MTOK, DM, G, bx); S.i0 = rnd; S.ni = 1;
          pg8::PanelStats st{(unsigned long long*)(ws + WS_XBUF + (size_t)(2 * l + 1) * 2 * MiB), (unsigned*)(ws + WS_PCNT + (size_t)(2 * l + 1) * 65536), LN_EPS};
          pg8::EpiLnFused E{(bf16*)(ws + WS_XN), XPTR, l == 0, IN(25) + l * DM, IN(26) + l * DM, ALPHA, st};
          pg8::gemm_phase<pg8::EpiLnFused>(lds, g, S, E, wave_id); }
        if (l == 0) { GRID_BAR(); NEXT_STAMP(); }
    }
    if (PROBE_ON && blockIdx.x == 0) {
        STAMP(stamp_id);
        __threadfence(); __syncthreads();
        volatile LAS unsigned long long* st = (volatile LAS unsigned long long*)(lds + MISC_OFF + 64);
        unsigned long long q1 = 0, q2 = 0;
        for (int k = 0; k < 31; ++k) { const unsigned long long d = st[k + 1] - st[k]; if ((PROBE_M1 >> k) & 1ull) q1 += d; if ((PROBE_M2 >> k) & 1ull) q2 += d; }
        if ((PROBE_M1 >> 40) & 1ull) q1 += st[40] - st[1];
        if ((PROBE_M2 >> 40) & 1ull) q2 += st[40] - st[1];
        if ((PROBE_M1 >> 41) & 1ull) q1 += (st[41] - st[5]) + (st[42] - st[17]);
        if ((PROBE_M2 >> 41) & 1ull) q2 += (st[41] - st[5]) + (st[42] - st[17]);
        const long K = (long)(q1 * 16ull / 100ull) < 262144l ? (long)(q1 * 16ull / 100ull) : 262144l;
        const __attribute__((address_space(4))) unsigned char* kp = (const __attribute__((address_space(4))) unsigned char*)__builtin_amdgcn_kernarg_segment_ptr();
        float* Xo = XPTR;
        for (long e = threadIdx.x; e < K; e += 512) { const long r = e >> 10, c = e & 1023; atomicAdd(Xo + ((r & 7) + 2048 * (r >> 3)) * 1024 + c, 0.125f); }
        if (threadIdx.x == 0) { const unsigned long long t0 = __builtin_amdgcn_s_memrealtime(); while (__builtin_amdgcn_s_memrealtime() - t0 < q2) __builtin_amdgcn_s_sleep(8); }
    }
}

extern "C" void kernel_launch(void* const* d_in, const int* in_sizes, int n_in, void* d_out, int out_size, void* d_ws, size_t ws_size, hipStream_t stream) {
    static int grid = 0;
    if (grid == 0) {
        if (n_in != 27 || out_size != MTOK * DM || ws_size < WS_END) { fprintf(stderr, "kernel_launch: unexpected shapes (n_in %d out %d ws %zu)\n", n_in, out_size, ws_size); grid = -1; return; }
        int dev = 0, cus = 0, per_cu = 0;
        hipGetDevice(&dev); hipDeviceGetAttribute(&cus, hipDeviceAttributeMultiprocessorCount, dev);
        if (hipFuncSetAttribute((const void*)fwd_megakernel, hipFuncAttributeMaxDynamicSharedMemorySize, LDS_BYTES) != hipSuccess) { fprintf(stderr, "kernel_launch: hipFuncSetAttribute failed\n"); grid = -1; return; }
        if (hipOccupancyMaxActiveBlocksPerMultiprocessor(&per_cu, (const void*)fwd_megakernel, 512, LDS_BYTES) != hipSuccess || per_cu < 1) { fprintf(stderr, "kernel_launch: occupancy query says %d\n", per_cu); per_cu = 1; }
        (void)hipGetLastError();
        grid = cus;
        if (grid > 256) grid = 256;
    }
    if (grid < 0) return;
    Args a{};
    for (int i = 0; i < 27; ++i) a.in[i] = (const float*)d_in[i];
    a.out = (float*)d_out; a.ws = (unsigned char*)d_ws;
    void* args[] = {&a};
    hipError_t e = hipLaunchCooperativeKernel((const void*)fwd_megakernel, dim3(grid), dim3(512), args, LDS_BYTES, stream);
    if (e != hipSuccess) fprintf(stderr, "cooperative launch failed: %s (grid %d)\n", hipGetErrorString(e), grid);
}
```

```cpp
#include <hip/hip_runtime.h>
#include <hip/hip_cooperative_groups.h>
#include <cstdio>
#include <cstdint>
namespace cg = cooperative_groups;

#define LAS __attribute__((address_space(3)))
typedef unsigned short bf16;
typedef short bf16x8 __attribute__((ext_vector_type(8)));
typedef float f32x4 __attribute__((ext_vector_type(4)));
typedef float f32x2 __attribute__((ext_vector_type(2)));
typedef unsigned u32x4 __attribute__((ext_vector_type(4)));
typedef unsigned u32x2 __attribute__((ext_vector_type(2)));

constexpr int NB = 32, SEQ = 2048, DM = 1024, MTOK = NB * SEQ;
constexpr int ZR_P = 1536, ZT_P = 1536, ZA_P = 768, LP_P = 1536, Y_P = 1024, KP_P = 1024;
constexpr int NIN = 3712, NIN_PAD = 3840, DFF = 2816, DFF2 = 5632, NLORA = 1280, KLORA = 256;
constexpr int MHALF = MTOK / 2;
constexpr float ALPHA = 1.41421356237309515f;
constexpr float LN_EPS = 1e-5f;

constexpr size_t MiB = 1u << 20;
constexpr size_t WS_CTL = 0;
constexpr size_t WS_ROPEC = 1 * MiB, WS_ROPES = WS_ROPEC + 256 * 1024, WS_GPOW = WS_ROPES + 256 * 1024;
constexpr size_t WS_W = 2 * MiB, W_LAYER = 27 * MiB;
constexpr size_t WO_IN = 0, WO_OUT = WO_IN + (size_t)NIN_PAD * DM * 2, WO_UP = WO_OUT + (size_t)DM * DM * 2,
                 WO_DN = WO_UP + (size_t)DFF2 * DM * 2, WO_LORA = WO_DN + (size_t)DM * DFF * 2, WO_END = WO_LORA + (size_t)NLORA * KLORA * 2;
static_assert(WO_END <= W_LAYER, "weights per layer");
constexpr size_t WS_XN = 64 * MiB, WS_Y = 192 * MiB, WS_ZR = 320 * MiB, WS_ZT = 512 * MiB, WS_ZA = 704 * MiB, WS_LP = 800 * MiB, WS_BONUS = 992 * MiB;
constexpr size_t WS_HH = 320 * MiB, WS_UB = 672 * MiB, WS_END = 1024 * MiB;
static_assert(WS_HH + (size_t)MTOK * DFF * 2 <= WS_UB && WS_UB + (size_t)(MTOK / 64) * 4 * DFF2 * 2 <= WS_END, "ffn map");

constexpr int LDS_BYTES = 147456;
constexpr int MISC_OFF = 131072;

#define KARG(off) (*(const float* const __attribute__((address_space(4)))*)(kp + (off)))
template <int N> __device__ __forceinline__ float dpp_ror(float x) { return __builtin_bit_cast(float, __builtin_amdgcn_update_dpp(0, __builtin_bit_cast(int, x), 0x120 + N, 0xf, 0xf, true)); }
namespace pg8 {
constexpr int BM = 256, BK = 64, HALF = 128, HTB = HALF * BK * 2, NXCD = 8, WGM = 8;
__host__ __device__ __forceinline__ int lds_byte(int r, int c) { const int st = (r >> 4) * 2 + (c >> 5), rr = r & 15, cc = c & 31, ob = rr * 64 + cc * 2; return st * 1024 + (ob ^ (((ob >> 9) & 1) << 5)); }
__host__ __device__ __forceinline__ void stage_rc(int b, int& R, int& C) { const int st = b / 1024, sb = b % 1024, swz = sb ^ (((sb >> 9) & 1) << 5); R = (st >> 1) * 16 + swz / 64; C = (st & 1) * 32 + (swz % 64) / 2; }
__host__ __device__ __forceinline__ int perm32(int rho) { const int n = rho >> 4, i = rho & 15; return 8 * (i >> 2) + 4 * n + (i & 3); }
struct Unit { int pm, pn; };
struct Gemm { const bf16* A; const bf16* Bt; int M, N, K, lda; };
struct StaticOrder {
    int nM, nN, nwg, G, c, i0, ni;
    __device__ void init(int M, int N, int G_, int c_) { nM = M / BM; nN = N / BM; nwg = nM * nN; G = G_; c = c_; i0 = 0; ni = 1 << 30; }
    __device__ bool next(int i, Unit& u) const {
        if (i >= ni) return false;
        const long L = (long)(i + i0) * G + c; if (L >= nwg) return false;
        int wgid = (int)L; { const int q = nwg / NXCD, r = nwg % NXCD, xcd = wgid % NXCD, off = wgid / NXCD; wgid = (xcd < r ? xcd * (q + 1) : r * (q + 1) + (xcd - r) * q) + off; }
        const int nig = WGM * nN, gid = wgid / nig, fm = gid * WGM, gsz = (nM - fm) < WGM ? (nM - fm) : WGM;
        u.pm = fm + ((wgid % nig) % gsz); u.pn = (wgid % nig) / gsz; return true;
    }
};
__device__ __forceinline__ unsigned cvt_pk_bf16(float lo, float hi) { unsigned r; asm volatile("v_cvt_pk_bf16_f32 %0, %1, %2" : "=v"(r) : "v"(lo), "v"(hi)); return r; }

struct EpiBf16 {
    static constexpr bool PERM = true, STAGED = false, AFTER_DRAIN = false;
    bf16* O; int ldc;
    __device__ __forceinline__ void operator()(const f32x4 (&acc)[2][2][4][2], const Unit& u, int wr, int wc, int fr, int fq) const {
        const int row0 = u.pm * BM + wr * 64 + fr, col0 = u.pn * BM + wc * 32 + 8 * fq;
#pragma unroll
        for (int ai = 0; ai < 2; ++ai)
#pragma unroll
            for (int m = 0; m < 4; ++m) { bf16* rowp = O + (size_t)(row0 + ai * HALF + m * 16) * ldc + col0;
#pragma unroll
                for (int bj = 0; bj < 2; ++bj) { const f32x4 v0 = acc[ai][bj][m][0], v1 = acc[ai][bj][m][1];
                    u32x4 w; w.x = cvt_pk_bf16(v0[0], v0[1]); w.y = cvt_pk_bf16(v0[2], v0[3]); w.z = cvt_pk_bf16(v1[0], v1[1]); w.w = cvt_pk_bf16(v1[2], v1[3]);
                    *(u32x4*)(rowp + bj * HALF) = w; } }
    }
};
struct EpiZ {
    static constexpr bool PERM = true, STAGED = false, AFTER_DRAIN = false;
    bf16 *Zr, *Zt, *Za;
    __device__ __forceinline__ void operator()(const f32x4 (&acc)[2][2][4][2], const Unit& u, int wr, int wc, int fr, int fq) const {
        bf16* base; int ldc, colt; float sc = 1.f;
        if (u.pn < 6) { base = Zr; ldc = ZR_P; colt = u.pn * BM; } else if (u.pn < 12) { base = Zt; ldc = ZT_P; colt = (u.pn - 6) * BM; } else { base = Za; ldc = ZA_P; colt = (u.pn - 12) * BM; if (u.pn == 12) sc = 0.125f; }
        const int row0 = u.pm * BM + wr * 64 + fr, col0 = colt + wc * 32 + 8 * fq;
#pragma unroll
        for (int ai = 0; ai < 2; ++ai)
#pragma unroll
            for (int m = 0; m < 4; ++m) { bf16* rowp = base + (size_t)(row0 + ai * HALF + m * 16) * ldc + col0;
#pragma unroll
                for (int bj = 0; bj < 2; ++bj) { const f32x4 v0 = acc[ai][bj][m][0] * sc, v1 = acc[ai][bj][m][1] * sc;
                    u32x4 w; w.x = cvt_pk_bf16(v0[0], v0[1]); w.y = cvt_pk_bf16(v0[2], v0[3]); w.z = cvt_pk_bf16(v1[0], v1[1]); w.w = cvt_pk_bf16(v1[2], v1[3]);
                    *(u32x4*)(rowp + bj * HALF) = w; } }
    }
};
struct EpiRes {
    static constexpr bool PERM = false, STAGED = false, AFTER_DRAIN = false;
    unsigned short* X; const bf16* Rb; float alpha;
    __device__ __forceinline__ void operator()(const f32x4 (&acc)[2][2][4][2], const Unit& u, int wr, int wc, int fr, int fq) const {
        const int row0 = u.pm * BM + wr * 64 + fr, col0 = u.pn * BM + wc * 32 + 4 * fq;
#pragma unroll
        for (int ai = 0; ai < 2; ++ai)
#pragma unroll
            for (int m = 0; m < 4; ++m) { const size_t off = (size_t)(row0 + ai * HALF + m * 16) * DM + col0;
#pragma unroll
                for (int bj = 0; bj < 2; ++bj)
#pragma unroll
                    for (int n = 0; n < 2; ++n) { const u32x2 r = *(const u32x2*)(Rb + off + bj * HALF + n * 16);
                        const f32x4 x = (f32x4){__builtin_bit_cast(float, r.x << 16), __builtin_bit_cast(float, r.x & 0xffff0000u), __builtin_bit_cast(float, r.y << 16), __builtin_bit_cast(float, r.y & 0xffff0000u)};
                        const f32x4 hv = x * alpha + acc[ai][bj][m][n];
                        u32x2 w;
                        w.x = (unsigned)__builtin_bit_cast(unsigned short, (_Float16)hv[0]) | ((unsigned)__builtin_bit_cast(unsigned short, (_Float16)hv[1]) << 16);
                        w.y = (unsigned)__builtin_bit_cast(unsigned short, (_Float16)hv[2]) | ((unsigned)__builtin_bit_cast(unsigned short, (_Float16)hv[3]) << 16);
                        *(u32x2*)(X + off + bj * HALF + n * 16) = w; } }
    }
};

template <int CTRL> __device__ __forceinline__ float dpp_keep(float old, float src) { return __builtin_bit_cast(float, __builtin_amdgcn_update_dpp(__builtin_bit_cast(int, old), __builtin_bit_cast(int, src), CTRL, 0xf, 0xf, false)); }
struct EpiConvGate {
    static constexpr bool PERM = false, STAGED = true, AFTER_DRAIN = false;
    const __attribute__((address_space(4))) unsigned char* kp; int l;
    LAS unsigned char* lp;
    __device__ __forceinline__ f32x2 load_params(const Unit& u, int tid) const {
        const float* cw = KARG(8 * 22) + (size_t)l * 3 * DFF2; const float* cb = KARG(8 * 23) + (size_t)l * DFF2;
        const int idx = 2 * tid, a = idx >> 7, c = idx & 127, j = 128 * u.pn + c;
        const float* src = ((a & 3) == 3) ? cb + j : cw + (a & 3) * DFF2 + j;
        if (a >= 4) src += DFF;
        return *(const f32x2*)src;
    }
    __device__ __forceinline__ void store_params(const f32x2 v, int buf, int tid) const { *(LAS f32x2*)(lp + buf * 4096 + tid * 8) = v; }
    __device__ __forceinline__ void run_staged(const f32x4 (&acc)[2][2][4][2], const Unit& u, int wr, int wc, int fr, int fq, int buf) const {
        unsigned char* ws_ = (unsigned char*)KARG(224);
        bf16* HH = (bf16*)(ws_ + WS_HH); bf16* UB = (bf16*)(ws_ + WS_UB);
        const LAS f32x4* P = (const LAS f32x4*)(lp + buf * 4096);
#pragma unroll
        for (int n = 0; n < 2; ++n) {
            asm volatile("" ::: "memory");
            const int j = 128 * u.pn + 32 * wc + 16 * n + 4 * fq;
            const int c4 = (32 * wc + 16 * n + 4 * fq) >> 2;
            const f32x4 wg0 = P[c4], wg1 = P[32 + c4], wg2 = P[64 + c4], bg = P[96 + c4], wv0 = P[128 + c4], wv1 = P[160 + c4], wv2 = P[192 + c4], bv = P[224 + c4];
#pragma unroll
            for (int ai = 0; ai < 2; ++ai) {
                const int blk = u.pm * 4 + ai * 2 + wr;
#pragma unroll
                for (int m = 0; m < 4; ++m) {
                    const f32x4 g0 = acc[ai][0][m][n], v0 = acc[ai][1][m][n];
                    const f32x4 gp = acc[ai][0][m > 0 ? m - 1 : 0][n], vp = acc[ai][1][m > 0 ? m - 1 : 0][n];
                    float h[4];
#pragma unroll
                    for (int i = 0; i < 4; ++i) {
                        const float g1 = dpp_keep<0x111>(dpp_ror<1>(gp[i]), g0[i]), g2 = dpp_keep<0x112>(dpp_ror<2>(gp[i]), g0[i]);
                        const float v1 = dpp_keep<0x111>(dpp_ror<1>(vp[i]), v0[i]), v2 = dpp_keep<0x112>(dpp_ror<2>(vp[i]), v0[i]);
                        const float cg = bg[i] + wg0[i] * g2 + wg1[i] * g1 + wg2[i] * g0[i];
                        const float cv = bv[i] + wv0[i] * v2 + wv1[i] * v1 + wv2[i] * v0[i];
                        h[i] = cg * cv * __builtin_amdgcn_rcpf(1.f + __expf(-cg));
                    }
                    const size_t row = (size_t)u.pm * BM + ai * HALF + wr * 64 + m * 16 + fr;
                    if (!(m == 0 && fr < 2)) { u32x2 w; w.x = cvt_pk_bf16(h[0], h[1]); w.y = cvt_pk_bf16(h[2], h[3]); *(u32x2*)(HH + row * DFF + j) = w; }
                    if ((m == 0 && fr < 2) || (m == 3 && fr >= 14)) {
                        const int rr = (m == 0) ? fr : fr - 12;
                        bf16* ub = UB + ((size_t)(blk * 4 + rr) * 2) * DFF + j;
                        u32x2 w; w.x = cvt_pk_bf16(g0[0], g0[1]); w.y = cvt_pk_bf16(g0[2], g0[3]); *(u32x2*)ub = w;
                        w.x = cvt_pk_bf16(v0[0], v0[1]); w.y = cvt_pk_bf16(v0[2], v0[3]); *(u32x2*)(ub + DFF) = w;
                    }
                    asm volatile("" ::: "memory");
                }
            }
        }
    }
};

__device__ __forceinline__ float xrow_sum_fwd(float v) {
    float a = v, b = v;
    asm volatile("s_nop 1\n\tv_permlane16_swap_b32 %0, %1" : "+v"(a), "+v"(b));
    const float s = a + b;
    float c = s, d = s;
    asm volatile("s_nop 1\n\tv_permlane32_swap_b32 %0, %1" : "+v"(c), "+v"(d));
    return c + d;
}
struct PanelStats {
    unsigned long long* xbuf;
    unsigned* cnt;
    float eps;
    __device__ __forceinline__ void run(const f32x4 (&v)[2][2][4][2], const Unit& u, int wr, int wc, int fr, int fq, LAS unsigned char* lds, int wid, int lane) const {
        LAS f32x2* P = (LAS f32x2*)lds;
        LAS f32x2* S = (LAS f32x2*)(lds + 8192);
#pragma unroll
        for (int ai = 0; ai < 2; ++ai)
#pragma unroll
            for (int m = 0; m < 4; ++m) {
                float s = 0.f;
#pragma unroll
                for (int bj = 0; bj < 2; ++bj)
#pragma unroll
                    for (int n = 0; n < 2; ++n) { const f32x4 x = v[ai][bj][m][n]; s += (x[0] + x[1]) + (x[2] + x[3]); }
                s = xrow_sum_fwd(s);
                const float mw = s * (1.0f / 64.0f); float q = 0.f;
#pragma unroll
                for (int bj = 0; bj < 2; ++bj)
#pragma unroll
                    for (int n = 0; n < 2; ++n) { const f32x4 d = v[ai][bj][m][n] - mw; q += (d[0] * d[0] + d[1] * d[1]) + (d[2] * d[2] + d[3] * d[3]); }
                q = xrow_sum_fwd(q);
                if (fq == 0) P[(ai * HALF + wr * 64 + m * 16 + fr) * 4 + wc] = (f32x2){mw, q};
            }
        asm volatile("s_waitcnt lgkmcnt(0)" ::: "memory"); __builtin_amdgcn_s_barrier(); asm volatile("" ::: "memory");
        const int row = wid * 32 + (lane & 31);
        if (lane < 32) {
            const f32x2 a = P[row * 4 + 0], b = P[row * 4 + 1], c = P[row * 4 + 2], d = P[row * 4 + 3];
            const float mt = (a.x + b.x + c.x + d.x) * 0.25f;
            const float da = a.x - mt, db = b.x - mt, dc = c.x - mt, dd = d.x - mt;
            const float m2 = (a.y + b.y) + (c.y + d.y) + 64.0f * ((da * da + db * db) + (dc * dc + dd * dd));
            unsigned long long* slot = xbuf + ((size_t)(u.pm * BM + row) * 4 + u.pn);
            __hip_atomic_store(slot, ((unsigned long long)__builtin_bit_cast(unsigned, m2) << 32) | __builtin_bit_cast(unsigned, mt), __ATOMIC_RELAXED, __HIP_MEMORY_SCOPE_AGENT);
        }
        asm volatile("s_waitcnt vmcnt(0)" ::: "memory");
        if (lane == 0) __hip_atomic_fetch_add(cnt + 64 * u.pm, 1u, __ATOMIC_RELAXED, __HIP_MEMORY_SCOPE_AGENT);
        if (wid == 0) {
            unsigned sp = 0u;
            while ((unsigned)__builtin_amdgcn_readfirstlane(__hip_atomic_load(cnt + 64 * u.pm, __ATOMIC_RELAXED, __HIP_MEMORY_SCOPE_AGENT)) < 32u) { __builtin_amdgcn_s_sleep(2); if (++sp > (1u << 22)) break; }
            __builtin_amdgcn_fence(__ATOMIC_ACQUIRE, "agent");
        }
        asm volatile("s_waitcnt vmcnt(0) lgkmcnt(0)" ::: "memory"); __builtin_amdgcn_s_barrier(); asm volatile("" ::: "memory");
        if (lane < 32) {
            const unsigned long long* slot = xbuf + (size_t)(u.pm * BM + row) * 4; float mt[4], m2[4]; float ms = 0.f;
#pragma unroll
            for (int t = 0; t < 4; ++t) { const unsigned long long w = __hip_atomic_load(slot + t, __ATOMIC_RELAXED, __HIP_MEMORY_SCOPE_AGENT); mt[t] = __builtin_bit_cast(float, (unsigned)w); m2[t] = __builtin_bit_cast(float, (unsigned)(w >> 32)); ms += mt[t]; }
            const float mean = ms * 0.25f; float q = 0.f;
#pragma unroll
            for (int t = 0; t < 4; ++t) { const float dm = mt[t] - mean; q += m2[t] + 256.0f * dm * dm; }
            S[row] = (f32x2){mean, 1.0f / sqrtf(q * (1.0f / 1024.0f) + eps)};
        }
        asm volatile("s_waitcnt lgkmcnt(0)" ::: "memory"); __builtin_amdgcn_s_barrier(); asm volatile("" ::: "memory");
    }
};
struct EpiLnFused {
    static constexpr bool PERM = false, STAGED = false, AFTER_DRAIN = true;
    bf16* XNb; float* outf; bool wr_bf; const float* g; const float* b; float alpha; PanelStats st;
    __device__ __forceinline__ void fused(f32x4 (&acc)[2][2][4][2], const Unit& u, int wr, int wc, int fr, int fq, LAS unsigned char* lds, int wid, int lane) const {
        const LAS f32x2* S = (const LAS f32x2*)(lds + 8192);
        const int col0 = u.pn * BM + wc * 32 + 4 * fq;
#pragma unroll
        for (int ai = 0; ai < 2; ++ai)
#pragma unroll
            for (int m = 0; m < 4; ++m) { const size_t off = (size_t)(u.pm * BM + ai * HALF + wr * 64 + m * 16 + fr) * DM + col0;
#pragma unroll
                for (int bj = 0; bj < 2; ++bj)
#pragma unroll
                    for (int n = 0; n < 2; ++n) { const u32x2 r = *(const u32x2*)(XNb + off + bj * HALF + n * 16);
                        const f32x4 x = (f32x4){__builtin_bit_cast(float, r.x << 16), __builtin_bit_cast(float, r.x & 0xffff0000u), __builtin_bit_cast(float, r.y << 16), __builtin_bit_cast(float, r.y & 0xffff0000u)};
                        acc[ai][bj][m][n] = x * alpha + acc[ai][bj][m][n]; }
                if (m & 1) asm volatile("" ::: "memory"); }
        st.run(acc, u, wr, wc, fr, fq, lds, wid, lane);
#pragma unroll
        for (int bj = 0; bj < 2; ++bj)
#pragma unroll
            for (int n = 0; n < 2; ++n) {
                const f32x4 gv = *(const f32x4*)(g + col0 + bj * HALF + n * 16), bv = *(const f32x4*)(b + col0 + bj * HALF + n * 16);
#pragma unroll
                for (int ai = 0; ai < 2; ++ai)
#pragma unroll
                    for (int m = 0; m < 4; ++m) { const int r = ai * HALF + wr * 64 + m * 16 + fr; const f32x2 sr = S[r]; const size_t off = (size_t)(u.pm * BM + r) * DM + col0 + bj * HALF + n * 16;
                        const f32x4 o = (acc[ai][bj][m][n] - sr.x) * sr.y * gv + bv;
                        if (wr_bf) { u32x2 w; w.x = cvt_pk_bf16(o[0], o[1]); w.y = cvt_pk_bf16(o[2], o[3]); *(u32x2*)(XNb + off) = w; }
                        else *(f32x4*)(outf + off) = o; }
                asm volatile("" ::: "memory"); }
        asm volatile("s_waitcnt lgkmcnt(0)" ::: "memory"); __builtin_amdgcn_s_barrier();
    }
};

template <class Epi>
__device__ __forceinline__ void gemm_phase(LAS unsigned char* lds, const Gemm g, const StaticOrder& S, const Epi& E, int wave_id) {
    unsigned ones_ = ~0u; asm volatile("" : "+s"(ones_));
    int tid = wave_id * 64 + (int)__builtin_amdgcn_mbcnt_hi(ones_, __builtin_amdgcn_mbcnt_lo(ones_, 0u)); asm volatile("" : "+v"(tid));
    const int wid = __builtin_amdgcn_readfirstlane(tid >> 6), lane = tid & 63, wr = wid >> 2, wc = wid & 3, fr = lane & 15, fq = lane >> 4;
    const int K = g.K, nt = K / BK, lda = g.lda;
    unsigned voffA[2], voffB[2];
#pragma unroll
    for (int i = 0; i < 2; ++i) { int R, C; stage_rc(tid * 16 + i * 8192, R, C); const int Rb = Epi::PERM ? ((R & ~31) + perm32(R & 31)) : R;
        voffA[i] = (unsigned)(R * lda + C) * 2u; voffB[i] = (unsigned)(Rb * K + C) * 2u; }
    const size_t kstep = (size_t)(BK * 2);
    const size_t hstepA = (size_t)HALF * lda * 2, hstepB = (size_t)HALF * K * 2;
    const size_t tstepA = 2 * hstepA, tstepB = 2 * hstepB;
    const unsigned ldsw = (unsigned)wid * 1024u;
    const int aoff = lds_byte(wr * 64 + fr, fq * 8), boff = lds_byte(wc * 32 + fr, fq * 8);
#define PG8_SA(b, h) (((b) * 2 + (h)) * HTB)
#define PG8_SB(b, h) ((4 + (b) * 2 + (h)) * HTB)
#define PG8_STAGE(bufoff, gbase, voff) do { _Pragma("unroll") for (int _i = 0; _i < 2; ++_i) \
        __builtin_amdgcn_global_load_lds((const unsigned*)((const char*)(gbase) + (voff)[_i]), (LAS unsigned*)(lds + (bufoff) + ldsw + _i * 8192), 16, 0, 0); } while (0)
#define PG8_LDA(dst, b, h) do { _Pragma("unroll") for (int m = 0; m < 4; ++m) _Pragma("unroll") for (int k = 0; k < 2; ++k) dst[m][k] = *(const LAS bf16x8*)(lds + PG8_SA(b, h) + aoff + m * 2048 + k * 1024); } while (0)
#define PG8_LDB(dst, b, h) do { _Pragma("unroll") for (int n = 0; n < 2; ++n) _Pragma("unroll") for (int k = 0; k < 2; ++k) dst[n][k] = *(const LAS bf16x8*)(lds + PG8_SB(b, h) + boff + n * 2048 + k * 1024); } while (0)
#define PG8_MMA(ai, bj, At, Bt) do { __builtin_amdgcn_s_setprio(1); _Pragma("unroll") for (int m = 0; m < 4; ++m) _Pragma("unroll") for (int n = 0; n < 2; ++n) _Pragma("unroll") for (int k = 0; k < 2; ++k) \
        acc[ai][bj][m][n] = __builtin_amdgcn_mfma_f32_16x16x32_bf16(Bt[n][k], At[m][k], acc[ai][bj][m][n], 0, 0, 0); __builtin_amdgcn_s_setprio(0); } while (0)
#define PG8_WAIT_V(n) asm volatile("s_waitcnt vmcnt(" #n ")" ::: "memory")
#define PG8_WAIT_L(n) asm volatile("s_waitcnt lgkmcnt(" #n ")" ::: "memory")
#define PG8_BAR __builtin_amdgcn_s_barrier()
#define PG8_SCHED __builtin_amdgcn_sched_barrier(0)
    Unit cur, nxt; int ui = 0;
    if (!S.next(0, cur)) return;
    f32x4 acc[2][2][4][2];
#pragma unroll
    for (int a = 0; a < 2; ++a)
#pragma unroll
        for (int b = 0; b < 2; ++b)
#pragma unroll
            for (int m = 0; m < 4; ++m)
#pragma unroll
                for (int n = 0; n < 2; ++n) acc[a][b][m][n] = (f32x4){0.f, 0.f, 0.f, 0.f};
    bf16x8 At[4][2], B0[2][2], B1[2][2];
    const char* cA = (const char*)g.A + (size_t)cur.pm * tstepA; const char* cB = (const char*)g.Bt + (size_t)cur.pn * tstepB;
    if constexpr (Epi::STAGED) { const f32x2 p0_ = E.load_params(cur, tid); E.store_params(p0_, 0, tid); }
    PG8_STAGE(PG8_SB(0, 0), cB, voffB); PG8_STAGE(PG8_SB(0, 1), cB + hstepB, voffB); PG8_STAGE(PG8_SA(0, 0), cA, voffA); PG8_STAGE(PG8_SA(0, 1), cA + hstepA, voffA);
    if (wr == 1) PG8_BAR;
    PG8_WAIT_V(2); PG8_BAR;
    PG8_STAGE(PG8_SB(1, 0), cB + kstep, voffB); PG8_STAGE(PG8_SA(1, 0), cA + kstep, voffA); PG8_STAGE(PG8_SB(1, 1), cB + hstepB + kstep, voffB);
    PG8_WAIT_V(6); PG8_BAR;
    for (;;) {
        const bool has_next = S.next(ui + 1, nxt);
        const char* nA = has_next ? (const char*)g.A + (size_t)nxt.pm * tstepA : cA; const char* nB = has_next ? (const char*)g.Bt + (size_t)nxt.pn * tstepB : cB;
        for (int t = 0; t < nt; t += 2) {
            const bool last = (t == nt - 2);
            const char* a1 = cA + (size_t)(t + 1) * kstep;
            const char* a2 = last ? nA : cA + (size_t)(t + 2) * kstep; const char* b2 = last ? nB : cB + (size_t)(t + 2) * kstep;
            const char* a3 = a2 + kstep; const char* b3 = b2 + kstep;
            PG8_LDB(B0, 0, 0); PG8_LDB(B1, 0, 1); PG8_SCHED; PG8_LDA(At, 0, 0); PG8_STAGE(PG8_SA(1, 1), a1 + hstepA, voffA);
            PG8_WAIT_V(8); PG8_WAIT_L(0); PG8_BAR; PG8_MMA(0, 0, At, B0); PG8_MMA(0, 1, At, B1); PG8_BAR; PG8_SCHED;
            PG8_LDA(At, 0, 1); PG8_STAGE(PG8_SB(0, 0), b2, voffB); PG8_STAGE(PG8_SB(0, 1), b2 + hstepB, voffB); PG8_STAGE(PG8_SA(0, 0), a2, voffA);
            PG8_WAIT_V(8); PG8_WAIT_L(0); PG8_BAR; PG8_MMA(1, 0, At, B0); PG8_MMA(1, 1, At, B1); PG8_BAR; PG8_SCHED;
            PG8_LDB(B0, 1, 0); PG8_LDB(B1, 1, 1); PG8_SCHED; PG8_LDA(At, 1, 0); PG8_STAGE(PG8_SA(0, 1), a2 + hstepA, voffA);
            PG8_WAIT_V(8); PG8_WAIT_L(0); PG8_BAR; PG8_MMA(0, 0, At, B0); PG8_MMA(0, 1, At, B1); PG8_BAR; PG8_SCHED;
            PG8_LDA(At, 1, 1); PG8_STAGE(PG8_SB(1, 0), b3, voffB); PG8_STAGE(PG8_SB(1, 1), b3 + hstepB, voffB); PG8_STAGE(PG8_SA(1, 0), a3, voffA);
            PG8_WAIT_V(8); PG8_WAIT_L(0); PG8_BAR; PG8_MMA(1, 0, At, B0); PG8_MMA(1, 1, At, B1); PG8_BAR; PG8_SCHED;
        }
        if (wr == 0) PG8_BAR;
        { unsigned o2 = ~0u; asm volatile("" : "+s"(o2));
          const int lane2 = (int)__builtin_amdgcn_mbcnt_hi(o2, __builtin_amdgcn_mbcnt_lo(o2, 0u));
          if constexpr (Epi::AFTER_DRAIN) { (void)lane2; }
          else if constexpr (Epi::STAGED) {
              const int tid2 = wid * 64 + lane2;
              f32x2 pn_ = (f32x2){0.f, 0.f}; if (has_next) pn_ = E.load_params(nxt, tid2);
              E.run_staged(acc, cur, wr, wc, lane2 & 15, lane2 >> 4, ui & 1);
              if (has_next) E.store_params(pn_, (ui + 1) & 1, tid2);
          } else { E(acc, cur, wr, wc, lane2 & 15, lane2 >> 4); } }
        if (!has_next) break;
#pragma unroll
        for (int a = 0; a < 2; ++a)
#pragma unroll
            for (int b = 0; b < 2; ++b)
#pragma unroll
                for (int m = 0; m < 4; ++m)
#pragma unroll
                    for (int n = 0; n < 2; ++n) acc[a][b][m][n] = (f32x4){0.f, 0.f, 0.f, 0.f};
        cur = nxt; cA = nA; cB = nB; ++ui;
        if (wr == 1) PG8_BAR;
    }
    PG8_WAIT_V(0);
    PG8_BAR;
    if constexpr (Epi::AFTER_DRAIN) {
        unsigned o3 = ~0u; asm volatile("" : "+s"(o3));
        const int lane3 = (int)__builtin_amdgcn_mbcnt_hi(o3, __builtin_amdgcn_mbcnt_lo(o3, 0u));
        E.fused(acc, cur, wr, wc, lane3 & 15, lane3 >> 4, lds, wid, lane3);
    }
#undef PG8_SA
#undef PG8_SB
#undef PG8_STAGE
#undef PG8_LDA
#undef PG8_LDB
#undef PG8_MMA
#undef PG8_WAIT_V
#undef PG8_WAIT_L
#undef PG8_BAR
#undef PG8_SCHED
}
}

__device__ __forceinline__ unsigned f2bf(float f) { unsigned u = __builtin_bit_cast(unsigned, f); return (u + 0x7fffu + ((u >> 16) & 1u)) >> 16; }
__device__ __forceinline__ unsigned pk2(float lo, float hi) { return f2bf(lo) | (f2bf(hi) << 16); }
__device__ __forceinline__ float bf2f(unsigned u) { return __builtin_bit_cast(float, u << 16); }
__device__ __forceinline__ float bflo(unsigned w) { return __builtin_bit_cast(float, w << 16); }
__device__ __forceinline__ float bfhi(unsigned w) { return __builtin_bit_cast(float, w & 0xffff0000u); }
__device__ __forceinline__ float wave_sum(float v) {
#pragma unroll
    for (int o = 1; o < 64; o <<= 1) v += __shfl_xor(v, o);
    return v;
}
__device__ __forceinline__ float row16_sum(float v) { v += __shfl_xor(v, 1); v += __shfl_xor(v, 2); v += __shfl_xor(v, 4); v += __shfl_xor(v, 8); return v; }
__device__ __forceinline__ float row16_max(float v) { v = fmaxf(v, __shfl_xor(v, 1)); v = fmaxf(v, __shfl_xor(v, 2)); v = fmaxf(v, __shfl_xor(v, 4)); v = fmaxf(v, __shfl_xor(v, 8)); return v; }
__device__ __forceinline__ float sigmoidf_(float x) { return __builtin_amdgcn_rcpf(1.f + __expf(-x)); }
__device__ __forceinline__ void unpack8(const u32x4 w, float (&o)[8]) { o[0] = bflo(w.x); o[1] = bfhi(w.x); o[2] = bflo(w.y); o[3] = bfhi(w.y); o[4] = bflo(w.z); o[5] = bfhi(w.z); o[6] = bflo(w.w); o[7] = bfhi(w.w); }
__device__ __forceinline__ u32x4 pack8(const float (&o)[8]) { u32x4 w; w.x = pk2(o[0], o[1]); w.y = pk2(o[2], o[3]); w.z = pk2(o[4], o[5]); w.w = pk2(o[6], o[7]); return w; }
#define LDS_WAIT() asm volatile("s_waitcnt lgkmcnt(0)" ::: "memory")

__device__ __forceinline__ int map_row(int n, int mode) {
    if (mode == 1) return n < 1408 ? n : n + 128;
    if (mode == 2) { if (n < DFF) return 256 * (n >> 7) + (n & 127); const int q = n - DFF; return 256 * (q >> 7) + 128 + (q & 127); }
    return n;
}
__device__ __forceinline__ void p0_transpose_item(const float* W, int K, int N, bf16* WT, int mode, LAS float* scr, int item, int lane) {
    const int nblk = N / 32, kb = item / nblk, nb = item % nblk, k0 = 64 * kb, n0 = 32 * nb;
#pragma unroll 8
    for (int i = 0; i < 32; ++i) { const int kk = 2 * i + (lane >> 5); scr[kk * 33 + (lane & 31)] = W[(size_t)(k0 + kk) * N + n0 + (lane & 31)]; }
    LDS_WAIT();
    const int c = lane & 7;
#pragma unroll
    for (int j = 0; j < 4; ++j) { const int n = (lane >> 3) + 8 * j; const LAS float* s = scr + (8 * c) * 33 + n;
        u32x4 o; o.x = pk2(s[0 * 33], s[1 * 33]); o.y = pk2(s[2 * 33], s[3 * 33]); o.z = pk2(s[4 * 33], s[5 * 33]); o.w = pk2(s[6 * 33], s[7 * 33]);
        *(u32x4*)(WT + (size_t)map_row(n0 + n, mode) * K + k0 + 8 * c) = o; }
    LDS_WAIT();
}
__device__ __forceinline__ void ln_row(const float* xrow, const float* g, const float* bta, float* orow, bf16* brow, int lane) {
    const f32x4* xr = (const f32x4*)xrow + lane;
    f32x4 v[4]; float s = 0.f;
#pragma unroll
    for (int j = 0; j < 4; ++j) { v[j] = xr[64 * j]; s += (v[j].x + v[j].y) + (v[j].z + v[j].w); }
    const float mean = wave_sum(s) * (1.f / DM); float s2 = 0.f;
#pragma unroll
    for (int j = 0; j < 4; ++j) { v[j] = v[j] - mean; s2 += (v[j].x * v[j].x + v[j].y * v[j].y) + (v[j].z * v[j].z + v[j].w * v[j].w); }
    const float rstd = 1.f / sqrtf(wave_sum(s2) * (1.f / DM) + LN_EPS);
#pragma unroll
    for (int j = 0; j < 4; ++j) { const f32x4 gg = *((const f32x4*)g + lane + 64 * j), bb = *((const f32x4*)bta + lane + 64 * j);
        const f32x4 o = v[j] * rstd * gg + bb;
        if (orow) *((f32x4*)orow + lane + 64 * j) = o;
        if (brow) { u32x2 w; w.x = pk2(o.x, o.y); w.y = pk2(o.z, o.w); *((u32x2*)brow + lane + 64 * j) = w; } }
}

__device__ __forceinline__ float wsum_dpp(float v);
__device__ __forceinline__ float wsum_dpp(float v);
__device__ __forceinline__ float h2f_lo(unsigned w) { return (float)__builtin_bit_cast(_Float16, (unsigned short)(w & 0xffffu)); }
__device__ __forceinline__ float h2f_hi(unsigned w) { return (float)__builtin_bit_cast(_Float16, (unsigned short)(w >> 16)); }
struct Rows2h { u32x4 q0, q1, r0, r1; };
__device__ __forceinline__ Rows2h ln_load2h(const unsigned short* x0, const unsigned short* x1, int lane) {
    Rows2h r; r.q0 = *((const u32x4*)x0 + 2 * lane); r.q1 = *((const u32x4*)x0 + 2 * lane + 1); r.r0 = *((const u32x4*)x1 + 2 * lane); r.r1 = *((const u32x4*)x1 + 2 * lane + 1); return r;
}
__device__ __forceinline__ void ln_row2h(const Rows2h& in, const float* g, const float* bta, float* o0, float* o1, bf16* b0, bf16* b1, int lane) {
    const u32x4 q0 = in.q0, q1 = in.q1, r0 = in.r0, r1 = in.r1;
    float v[16], w[16];
    { const unsigned qa[8] = {q0.x, q0.y, q0.z, q0.w, q1.x, q1.y, q1.z, q1.w}, ra[8] = {r0.x, r0.y, r0.z, r0.w, r1.x, r1.y, r1.z, r1.w};
#pragma unroll
      for (int i = 0; i < 8; ++i) { v[2 * i] = h2f_lo(qa[i]); v[2 * i + 1] = h2f_hi(qa[i]); w[2 * i] = h2f_lo(ra[i]); w[2 * i + 1] = h2f_hi(ra[i]); } }
    float s = 0.f, t = 0.f;
#pragma unroll
    for (int i = 0; i < 16; ++i) { s += v[i]; t += w[i]; }
    const float mean0 = wsum_dpp(s) * (1.f / DM), mean1 = wsum_dpp(t) * (1.f / DM); float s2 = 0.f, t2 = 0.f;
#pragma unroll
    for (int i = 0; i < 16; ++i) { v[i] -= mean0; w[i] -= mean1; s2 += v[i] * v[i]; t2 += w[i] * w[i]; }
    const float rstd0 = 1.f / sqrtf(wsum_dpp(s2) * (1.f / DM) + LN_EPS), rstd1 = 1.f / sqrtf(wsum_dpp(t2) * (1.f / DM) + LN_EPS);
#pragma unroll
    for (int j = 0; j < 4; ++j) { const f32x4 gg = *((const f32x4*)g + 4 * lane + j), bb = *((const f32x4*)bta + 4 * lane + j);
        const f32x4 p = (f32x4){v[4 * j], v[4 * j + 1], v[4 * j + 2], v[4 * j + 3]} * rstd0 * gg + bb, q = (f32x4){w[4 * j], w[4 * j + 1], w[4 * j + 2], w[4 * j + 3]} * rstd1 * gg + bb;
        if (o0) { *((f32x4*)o0 + 4 * lane + j) = p; *((f32x4*)o1 + 4 * lane + j) = q; }
        if (b0) { u32x2 z; z.x = pk2(p.x, p.y); z.y = pk2(p.z, p.w); *((u32x2*)b0 + 4 * lane + j) = z; z.x = pk2(q.x, q.y); z.y = pk2(q.z, q.w); *((u32x2*)b1 + 4 * lane + j) = z; } }
}
struct Rows2f { f32x4 v[4], w[4]; };
__device__ __forceinline__ Rows2f ln_load2f(const float* x0, const float* x1, int lane) {
    Rows2f r; const f32x4* xr0 = (const f32x4*)x0 + lane; const f32x4* xr1 = (const f32x4*)x1 + lane;
#pragma unroll
    for (int j = 0; j < 4; ++j) { r.v[j] = xr0[64 * j]; r.w[j] = xr1[64 * j]; }
    return r;
}
__device__ __forceinline__ void ln_row2(const Rows2f& in, const float* g, const float* bta, float* o0, float* o1, bf16* b0, bf16* b1, int lane) {
    f32x4 v[4], w[4]; float s = 0.f, t = 0.f;
#pragma unroll
    for (int j = 0; j < 4; ++j) { v[j] = in.v[j]; w[j] = in.w[j]; }
#pragma unroll
    for (int j = 0; j < 4; ++j) { s += (v[j].x + v[j].y) + (v[j].z + v[j].w); t += (w[j].x + w[j].y) + (w[j].z + w[j].w); }
    const float mean0 = wsum_dpp(s) * (1.f / DM), mean1 = wsum_dpp(t) * (1.f / DM); float s2 = 0.f, t2 = 0.f;
#pragma unroll
    for (int j = 0; j < 4; ++j) { v[j] = v[j] - mean0; w[j] = w[j] - mean1;
        s2 += (v[j].x * v[j].x + v[j].y * v[j].y) + (v[j].z * v[j].z + v[j].w * v[j].w); t2 += (w[j].x * w[j].x + w[j].y * w[j].y) + (w[j].z * w[j].z + w[j].w * w[j].w); }
    const float rstd0 = 1.f / sqrtf(wsum_dpp(s2) * (1.f / DM) + LN_EPS), rstd1 = 1.f / sqrtf(wsum_dpp(t2) * (1.f / DM) + LN_EPS);
#pragma unroll
    for (int j = 0; j < 4; ++j) { const f32x4 gg = *((const f32x4*)g + lane + 64 * j), bb = *((const f32x4*)bta + lane + 64 * j);
        const f32x4 p = v[j] * rstd0 * gg + bb, q = w[j] * rstd1 * gg + bb;
        if (o0) { *((f32x4*)o0 + lane + 64 * j) = p; *((f32x4*)o1 + lane + 64 * j) = q; }
        if (b0) { u32x2 z; z.x = pk2(p.x, p.y); z.y = pk2(p.z, p.w); *((u32x2*)b0 + lane + 64 * j) = z; z.x = pk2(q.x, q.y); z.y = pk2(q.z, q.w); *((u32x2*)b1 + lane + 64 * j) = z; } }
}

__device__ __forceinline__ float xrow_sum(float v) {
    float a = v, b = v;
    asm volatile("s_nop 1\n\tv_permlane16_swap_b32 %0, %1" : "+v"(a), "+v"(b));
    const float s = a + b;
    float c = s, d = s;
    asm volatile("s_nop 1\n\tv_permlane32_swap_b32 %0, %1" : "+v"(c), "+v"(d));
    return c + d;
}
__device__ __forceinline__ float hlo(unsigned w) { return (float)__builtin_bit_cast(_Float16, (unsigned short)(w & 0xffffu)); }
__device__ __forceinline__ float hhi(unsigned w) { return (float)__builtin_bit_cast(_Float16, (unsigned short)(w >> 16)); }
__device__ __forceinline__ unsigned pkh2(float lo, float hi) { return (unsigned)__builtin_bit_cast(unsigned short, (_Float16)lo) | ((unsigned)__builtin_bit_cast(unsigned short, (_Float16)hi) << 16); }
constexpr int REC_STEP = 640;
template <int I> __device__ __forceinline__ float bc16(float x) {
    return __builtin_bit_cast(float, __builtin_amdgcn_update_dpp(0, __builtin_bit_cast(int, x), 0x150 + I, 0xf, 0xf, true));
}
__device__ __forceinline__ void rwkv_scan(int bh, int wv, int lane, const bf16* Zr, const unsigned char* REC, bf16* Y, const float* mu) {
    const int b = bh / 6, h = bh % 6, vl = lane & 15, kq = lane >> 4;
    const size_t m0 = (size_t)b * SEQ;
    const unsigned short* prec = (const unsigned short*)(REC + (size_t)bh * SEQ * REC_STEP) + lane;
    const bf16* pv = Zr + m0 * ZR_P + 768 + h * 64 + 16 * wv + vl;
    bf16* py = Y + m0 * Y_P + h * 64 + 16 * wv + vl;
    const float muv = mu[768 + h * 64 + 16 * wv + vl];
    float s[16];
#pragma unroll
    for (int i = 0; i < 16; ++i) s[i] = 0.f;
    constexpr int PD = 16;
    unsigned br[PD], bv[PD], be[PD], bb[PD], bk[PD], bn[PD];
#pragma unroll
    for (int j = 0; j < PD; ++j) { br[j] = prec[(size_t)j * 320]; be[j] = prec[(size_t)j * 320 + 64]; bk[j] = prec[(size_t)j * 320 + 128]; bn[j] = prec[(size_t)j * 320 + 192]; bb[j] = prec[(size_t)j * 320 + 256]; bv[j] = pv[(size_t)j * ZR_P]; }
    float vprev = 0.f;
    for (int t0 = 0; t0 < SEQ; t0 += PD) {
#pragma unroll
        for (int j = 0; j < PD; ++j) {
            const int t = t0 + j;
            const float rs = hlo(br[j]), xd = hlo(be[j]), kv = hlo(bk[j]), av = -hlo(bn[j]), bvv = hlo(bb[j]), vr = bf2f(bv[j]);
            { const int tn = (t + PD < SEQ) ? t + PD : SEQ - 1;
              br[j] = prec[(size_t)tn * 320]; be[j] = prec[(size_t)tn * 320 + 64]; bk[j] = prec[(size_t)tn * 320 + 128]; bn[j] = prec[(size_t)tn * 320 + 192]; bb[j] = prec[(size_t)tn * 320 + 256]; bv[j] = pv[(size_t)tn * ZR_P]; }
            const float vs = vr + (vprev - vr) * muv; vprev = vr;
            const float dec = 1.f - xd;
            float sa0, sa1;
            asm volatile(
                "s_nop 1\n\t"
                "v_mul_f32_dpp %0, %2, %3 row_newbcast:0 row_mask:0xf bank_mask:0xf\n\t"
                "v_mul_f32_dpp %1, %2, %4 row_newbcast:1 row_mask:0xf bank_mask:0xf\n\t"
                "v_fmac_f32_dpp %0, %2, %5 row_newbcast:2 row_mask:0xf bank_mask:0xf\n\t"
                "v_fmac_f32_dpp %1, %2, %6 row_newbcast:3 row_mask:0xf bank_mask:0xf\n\t"
                "v_fmac_f32_dpp %0, %2, %7 row_newbcast:4 row_mask:0xf bank_mask:0xf\n\t"
                "v_fmac_f32_dpp %1, %2, %8 row_newbcast:5 row_mask:0xf bank_mask:0xf\n\t"
                "v_fmac_f32_dpp %0, %2, %9 row_newbcast:6 row_mask:0xf bank_mask:0xf\n\t"
                "v_fmac_f32_dpp %1, %2, %10 row_newbcast:7 row_mask:0xf bank_mask:0xf\n\t"
                "v_fmac_f32_dpp %0, %2, %11 row_newbcast:8 row_mask:0xf bank_mask:0xf\n\t"
                "v_fmac_f32_dpp %1, %2, %12 row_newbcast:9 row_mask:0xf bank_mask:0xf\n\t"
                "v_fmac_f32_dpp %0, %2, %13 row_newbcast:10 row_mask:0xf bank_mask:0xf\n\t"
                "v_fmac_f32_dpp %1, %2, %14 row_newbcast:11 row_mask:0xf bank_mask:0xf\n\t"
                "v_fmac_f32_dpp %0, %2, %15 row_newbcast:12 row_mask:0xf bank_mask:0xf\n\t"
                "v_fmac_f32_dpp %1, %2, %16 row_newbcast:13 row_mask:0xf bank_mask:0xf\n\t"
                "v_fmac_f32_dpp %0, %2, %17 row_newbcast:14 row_mask:0xf bank_mask:0xf\n\t"
                "v_fmac_f32_dpp %1, %2, %18 row_newbcast:15 row_mask:0xf bank_mask:0xf\n\t"
                : "=&v"(sa0), "=&v"(sa1) : "v"(av), "v"(s[0]), "v"(s[1]), "v"(s[2]), "v"(s[3]), "v"(s[4]), "v"(s[5]), "v"(s[6]), "v"(s[7]), "v"(s[8]), "v"(s[9]), "v"(s[10]), "v"(s[11]), "v"(s[12]), "v"(s[13]), "v"(s[14]), "v"(s[15]));
            float sa = xrow_sum(sa0 + sa1);
            float y0 = 0.f, y1 = 0.f;
            asm volatile(
                "s_nop 1\n\t"
                "v_mul_f32_dpp %[s0], %[dec], %[s0] row_newbcast:0 row_mask:0xf bank_mask:0xf\n\t"
                "v_mul_f32_dpp %[s1], %[dec], %[s1] row_newbcast:1 row_mask:0xf bank_mask:0xf\n\t"
                "v_fmac_f32_dpp %[s0], %[bv], %[sa] row_newbcast:0 row_mask:0xf bank_mask:0xf\n\t"
                "v_fmac_f32_dpp %[s1], %[bv], %[sa] row_newbcast:1 row_mask:0xf bank_mask:0xf\n\t"
                "v_fmac_f32_dpp %[s0], %[kv], %[vs] row_newbcast:0 row_mask:0xf bank_mask:0xf\n\t"
                "v_fmac_f32_dpp %[s1], %[kv], %[vs] row_newbcast:1 row_mask:0xf bank_mask:0xf\n\t"
                "v_fmac_f32_dpp %[y], %[rs], %[s0] row_newbcast:0 row_mask:0xf bank_mask:0xf\n\t"
                "v_fmac_f32_dpp %[y], %[rs], %[s1] row_newbcast:1 row_mask:0xf bank_mask:0xf\n\t"
                "v_mul_f32_dpp %[s2], %[dec], %[s2] row_newbcast:2 row_mask:0xf bank_mask:0xf\n\t"
                "v_mul_f32_dpp %[s3], %[dec], %[s3] row_newbcast:3 row_mask:0xf bank_mask:0xf\n\t"
                "v_fmac_f32_dpp %[s2], %[bv], %[sa] row_newbcast:2 row_mask:0xf bank_mask:0xf\n\t"
                "v_fmac_f32_dpp %[s3], %[bv], %[sa] row_newbcast:3 row_mask:0xf bank_mask:0xf\n\t"
                "v_fmac_f32_dpp %[s2], %[kv], %[vs] row_newbcast:2 row_mask:0xf bank_mask:0xf\n\t"
                "v_fmac_f32_dpp %[s3], %[kv], %[vs] row_newbcast:3 row_mask:0xf bank_mask:0xf\n\t"
                "v_fmac_f32_dpp %[y], %[rs], %[s2] row_newbcast:2 row_mask:0xf bank_mask:0xf\n\t"
                "v_fmac_f32_dpp %[y], %[rs], %[s3] row_newbcast:3 row_mask:0xf bank_mask:0xf\n\t"
                "v_mul_f32_dpp %[s4], %[dec], %[s4] row_newbcast:4 row_mask:0xf bank_mask:0xf\n\t"
                "v_mul_f32_dpp %[s5], %[dec], %[s5] row_newbcast:5 row_mask:0xf bank_mask:0xf\n\t"
                "v_fmac_f32_dpp %[s4], %[bv], %[sa] row_newbcast:4 row_mask:0xf bank_mask:0xf\n\t"
                "v_fmac_f32_dpp %[s5], %[bv], %[sa] row_newbcast:5 row_mask:0xf bank_mask:0xf\n\t"
                "v_fmac_f32_dpp %[s4], %[kv], %[vs] row_newbcast:4 row_mask:0xf bank_mask:0xf\n\t"
                "v_fmac_f32_dpp %[s5], %[kv], %[vs] row_newbcast:5 row_mask:0xf bank_mask:0xf\n\t"
                "v_fmac_f32_dpp %[y], %[rs], %[s4] row_newbcast:4 row_mask:0xf bank_mask:0xf\n\t"
                "v_fmac_f32_dpp %[y], %[rs], %[s5] row_newbcast:5 row_mask:0xf bank_mask:0xf\n\t"
                "v_mul_f32_dpp %[s6], %[dec], %[s6] row_newbcast:6 row_mask:0xf bank_mask:0xf\n\t"
                "v_mul_f32_dpp %[s7], %[dec], %[s7] row_newbcast:7 row_mask:0xf bank_mask:0xf\n\t"
                "v_fmac_f32_dpp %[s6], %[bv], %[sa] row_newbcast:6 row_mask:0xf bank_mask:0xf\n\t"
                "v_fmac_f32_dpp %[s7], %[bv], %[sa] row_newbcast:7 row_mask:0xf bank_mask:0xf\n\t"
                "v_fmac_f32_dpp %[s6], %[kv], %[vs] row_newbcast:6 row_mask:0xf bank_mask:0xf\n\t"
                "v_fmac_f32_dpp %[s7], %[kv], %[vs] row_newbcast:7 row_mask:0xf bank_mask:0xf\n\t"
                "v_fmac_f32_dpp %[y], %[rs], %[s6] row_newbcast:6 row_mask:0xf bank_mask:0xf\n\t"
                "v_fmac_f32_dpp %[y], %[rs], %[s7] row_newbcast:7 row_mask:0xf bank_mask:0xf\n\t"
                : [s0]"+v"(s[0]), [s1]"+v"(s[1]), [s2]"+v"(s[2]), [s3]"+v"(s[3]), [s4]"+v"(s[4]), [s5]"+v"(s[5]), [s6]"+v"(s[6]), [s7]"+v"(s[7]), [y]"+v"(y0)
                : [dec]"v"(dec), [bv]"v"(bvv), [kv]"v"(kv), [rs]"v"(rs), [sa]"v"(sa), [vs]"v"(vs));
            asm volatile(
                "s_nop 1\n\t"
                "v_mul_f32_dpp %[s8], %[dec], %[s8] row_newbcast:8 row_mask:0xf bank_mask:0xf\n\t"
                "v_mul_f32_dpp %[s9], %[dec], %[s9] row_newbcast:9 row_mask:0xf bank_mask:0xf\n\t"
                "v_fmac_f32_dpp %[s8], %[bv], %[sa] row_newbcast:8 row_mask:0xf bank_mask:0xf\n\t"
                "v_fmac_f32_dpp %[s9], %[bv], %[sa] row_newbcast:9 row_mask:0xf bank_mask:0xf\n\t"
                "v_fmac_f32_dpp %[s8], %[kv], %[vs] row_newbcast:8 row_mask:0xf bank_mask:0xf\n\t"
                "v_fmac_f32_dpp %[s9], %[kv], %[vs] row_newbcast:9 row_mask:0xf bank_mask:0xf\n\t"
                "v_fmac_f32_dpp %[y], %[rs], %[s8] row_newbcast:8 row_mask:0xf bank_mask:0xf\n\t"
                "v_fmac_f32_dpp %[y], %[rs], %[s9] row_newbcast:9 row_mask:0xf bank_mask:0xf\n\t"
                "v_mul_f32_dpp %[s10], %[dec], %[s10] row_newbcast:10 row_mask:0xf bank_mask:0xf\n\t"
                "v_mul_f32_dpp %[s11], %[dec], %[s11] row_newbcast:11 row_mask:0xf bank_mask:0xf\n\t"
                "v_fmac_f32_dpp %[s10], %[bv], %[sa] row_newbcast:10 row_mask:0xf bank_mask:0xf\n\t"
                "v_fmac_f32_dpp %[s11], %[bv], %[sa] row_newbcast:11 row_mask:0xf bank_mask:0xf\n\t"
                "v_fmac_f32_dpp %[s10], %[kv], %[vs] row_newbcast:10 row_mask:0xf bank_mask:0xf\n\t"
                "v_fmac_f32_dpp %[s11], %[kv], %[vs] row_newbcast:11 row_mask:0xf bank_mask:0xf\n\t"
                "v_fmac_f32_dpp %[y], %[rs], %[s10] row_newbcast:10 row_mask:0xf bank_mask:0xf\n\t"
                "v_fmac_f32_dpp %[y], %[rs], %[s11] row_newbcast:11 row_mask:0xf bank_mask:0xf\n\t"
                "v_mul_f32_dpp %[s12], %[dec], %[s12] row_newbcast:12 row_mask:0xf bank_mask:0xf\n\t"
                "v_mul_f32_dpp %[s13], %[dec], %[s13] row_newbcast:13 row_mask:0xf bank_mask:0xf\n\t"
                "v_fmac_f32_dpp %[s12], %[bv], %[sa] row_newbcast:12 row_mask:0xf bank_mask:0xf\n\t"
                "v_fmac_f32_dpp %[s13], %[bv], %[sa] row_newbcast:13 row_mask:0xf bank_mask:0xf\n\t"
                "v_fmac_f32_dpp %[s12], %[kv], %[vs] row_newbcast:12 row_mask:0xf bank_mask:0xf\n\t"
                "v_fmac_f32_dpp %[s13], %[kv], %[vs] row_newbcast:13 row_mask:0xf bank_mask:0xf\n\t"
                "v_fmac_f32_dpp %[y], %[rs], %[s12] row_newbcast:12 row_mask:0xf bank_mask:0xf\n\t"
                "v_fmac_f32_dpp %[y], %[rs], %[s13] row_newbcast:13 row_mask:0xf bank_mask:0xf\n\t"
                "v_mul_f32_dpp %[s14], %[dec], %[s14] row_newbcast:14 row_mask:0xf bank_mask:0xf\n\t"
                "v_mul_f32_dpp %[s15], %[dec], %[s15] row_newbcast:15 row_mask:0xf bank_mask:0xf\n\t"
                "v_fmac_f32_dpp %[s14], %[bv], %[sa] row_newbcast:14 row_mask:0xf bank_mask:0xf\n\t"
                "v_fmac_f32_dpp %[s15], %[bv], %[sa] row_newbcast:15 row_mask:0xf bank_mask:0xf\n\t"
                "v_fmac_f32_dpp %[s14], %[kv], %[vs] row_newbcast:14 row_mask:0xf bank_mask:0xf\n\t"
                "v_fmac_f32_dpp %[s15], %[kv], %[vs] row_newbcast:15 row_mask:0xf bank_mask:0xf\n\t"
                "v_fmac_f32_dpp %[y], %[rs], %[s14] row_newbcast:14 row_mask:0xf bank_mask:0xf\n\t"
                "v_fmac_f32_dpp %[y], %[rs], %[s15] row_newbcast:15 row_mask:0xf bank_mask:0xf\n\t"
                : [s8]"+v"(s[8]), [s9]"+v"(s[9]), [s10]"+v"(s[10]), [s11]"+v"(s[11]), [s12]"+v"(s[12]), [s13]"+v"(s[13]), [s14]"+v"(s[14]), [s15]"+v"(s[15]), [y]"+v"(y1)
                : [dec]"v"(dec), [bv]"v"(bvv), [kv]"v"(kv), [rs]"v"(rs), [sa]"v"(sa), [vs]"v"(vs));
            const float y = xrow_sum(y0 + y1);
            if (kq == 0) py[(size_t)t * Y_P] = (bf16)f2bf(y);
        }
    }
}

__device__ __forceinline__ float row16_allsum(float v) { v += dpp_ror<8>(v); v += dpp_ror<4>(v); v += dpp_ror<2>(v); v += dpp_ror<1>(v); return v; }
__device__ __forceinline__ float wave_allsum(float v) { return xrow_sum(row16_allsum(v)); }
__device__ __forceinline__ float wsum_dpp(float v) { return wave_allsum(v); }
__device__ __forceinline__ float row16_allmax(float v) { v = fmaxf(v, dpp_ror<8>(v)); v = fmaxf(v, dpp_ror<4>(v)); v = fmaxf(v, dpp_ror<2>(v)); v = fmaxf(v, dpp_ror<1>(v)); return v; }
#define SCAN_BAR() asm volatile("s_waitcnt lgkmcnt(0)\n\ts_barrier" ::: "memory")
__device__ __forceinline__ float lds_sum8_st64(const LAS float* p) {
    f32x2 a, b, c, d;
    const unsigned addr = (unsigned)(unsigned long long)p;
    asm volatile("ds_read2st64_b32 %0, %4 offset1:1\n\tds_read2st64_b32 %1, %4 offset0:2 offset1:3\n\tds_read2st64_b32 %2, %4 offset0:4 offset1:5\n\tds_read2st64_b32 %3, %4 offset0:6 offset1:7\n\ts_waitcnt lgkmcnt(0)"
                 : "=&v"(a), "=&v"(b), "=&v"(c), "=&v"(d) : "v"(addr) : "memory");
    return ((a.x + a.y) + (b.x + b.y)) + ((c.x + c.y) + (d.x + d.y));
}
__device__ __forceinline__ void rwkv_scan2(LAS unsigned char* lds, int bh, int w, int lane, const bf16* Zr, const bf16* LP, const unsigned char* REC, const float* BONUS, bf16* Y,
                                           const float* mu, const float* lng, const float* lnb) {
    const int b = bh / 6, h = bh % 6;
    const size_t m0 = (size_t)b * SEQ;
    const u32x4* rec = (const u32x4*)(REC + (size_t)bh * SEQ * REC_STEP + w * 16);
    const bf16* pv = Zr + m0 * ZR_P + 768 + h * 64 + lane;
    const bf16* pg = LP + m0 * LP_P + 1024 + h * 64 + lane;
    const float* pbon = BONUS + m0 * 6 + h;
    bf16* py = Y + m0 * Y_P + h * 64 + lane;
    const float muv = mu[768 + h * 64 + lane], lg = lng[h * 64 + lane], lb = lnb[h * 64 + lane];
    LAS float* ex = (LAS float*)lds;
    LAS float* ey = (LAS float*)(lds + 4096);
    float s[8];
#pragma unroll
    for (int i = 0; i < 8; ++i) s[i] = 0.f;
    constexpr int PD = 4;
    bf16 bv[PD];
#pragma unroll
    for (int j = 0; j < PD; ++j) bv[j] = pv[(size_t)j * ZR_P];
    bf16 gq = pg[(size_t)w * LP_P]; float bq = pbon[(size_t)w * 6];
    u32x4 raw[PD][5];
#pragma unroll
    for (int p = 0; p < PD; ++p)
#pragma unroll
        for (int j = 0; j < 5; ++j) raw[p][j] = rec[p * (REC_STEP / 16) + j * 8];
    float vprev = 0.f, vs_last = 0.f;
    for (int t0 = 0; t0 < SEQ; t0 += PD) {
#pragma unroll
        for (int jj = 0; jj < PD; ++jj) {
            const int t = t0 + jj;
            float rk[8], xk[8], kk[8], ak[8], bk[8];
#define UNPK(dst, q) { dst[0] = hlo(q.x); dst[1] = hhi(q.x); dst[2] = hlo(q.y); dst[3] = hhi(q.y); dst[4] = hlo(q.z); dst[5] = hhi(q.z); dst[6] = hlo(q.w); dst[7] = hhi(q.w); }
            UNPK(rk, raw[jj][0]) UNPK(xk, raw[jj][1]) UNPK(kk, raw[jj][2]) UNPK(ak, raw[jj][3]) UNPK(bk, raw[jj][4])
#undef UNPK
            { const int tn = (t + PD < SEQ) ? t + PD : SEQ - 1;
#pragma unroll
              for (int j = 0; j < 5; ++j) raw[jj][j] = rec[tn * (REC_STEP / 16) + j * 8]; }
            const float vr = bf2f(bv[jj]);
            { const int tn = (t + PD < SEQ) ? t + PD : SEQ - 1; bv[jj] = pv[(size_t)tn * ZR_P]; }
            const float vs = vr + (vprev - vr) * muv; vprev = vr;
            float sap = 0.f;
#pragma unroll
            for (int i = 0; i < 8; ++i) sap = __builtin_fmaf(s[i], ak[i], sap);
            ex[((t & 1) * 8 + w) * 64 + lane] = sap;
            SCAN_BAR();
            const float nsa = -lds_sum8_st64(ex + (t & 1) * 512 + lane);
            float yp = 0.f;
#pragma unroll
            for (int i = 0; i < 8; ++i) { float tt = __builtin_fmaf(-xk[i], s[i], s[i]); tt = __builtin_fmaf(nsa, bk[i], tt); tt = __builtin_fmaf(vs, kk[i], tt); s[i] = tt; yp = __builtin_fmaf(tt, rk[i], yp); }
            ey[((t & 1) * 8 + w) * 64 + lane] = yp;
            if (t > 0 && ((t - 1) & 7) == w) {
                const int tp = t - 1;
                const float y = lds_sum8_st64(ey + (tp & 1) * 512 + lane);
                const float mean = wave_allsum(y) * (1.f / 64.f);
                const float d = y - mean;
                const float var = wave_allsum(d * d) * (1.f / 64.f);
                const float o = (d * (1.f / sqrtf(var + 64e-5f)) * lg + lb + bq * vs_last) * bf2f(gq);
                py[(size_t)tp * Y_P] = (bf16)f2bf(o);
                const int tq = (tp + 8 < SEQ) ? tp + 8 : SEQ - 1;
                gq = pg[(size_t)tq * LP_P]; bq = pbon[(size_t)tq * 6];
            }
            vs_last = vs;
        }
    }
    SCAN_BAR();
    if (((SEQ - 1) & 7) == w) {
        const int tp = SEQ - 1;
        const float y = lds_sum8_st64(ey + (tp & 1) * 512 + lane);
        const float mean = wave_allsum(y) * (1.f / 64.f);
        const float d = y - mean;
        const float var = wave_allsum(d * d) * (1.f / 64.f);
        const float o = (d * (1.f / sqrtf(var + 64e-5f)) * lg + lb + bq * vs_last) * bf2f(gq);
        py[(size_t)tp * Y_P] = (bf16)f2bf(o);
    }
}

struct HalfBar { LAS unsigned* ctr; unsigned target; };
__device__ __forceinline__ void hbar(HalfBar& hb, int lt) {
    asm volatile("s_waitcnt lgkmcnt(0)" ::: "memory");
    if ((lt & 63) == 0) __hip_atomic_fetch_add(hb.ctr, 1u, __ATOMIC_RELAXED, __HIP_MEMORY_SCOPE_WORKGROUP);
    hb.target += 4u;
    while (__hip_atomic_load(hb.ctr, __ATOMIC_RELAXED, __HIP_MEMORY_SCOPE_WORKGROUP) < hb.target) __builtin_amdgcn_s_sleep(1);
    asm volatile("" ::: "memory");
}
#define MFMA16(a, b, c) __builtin_amdgcn_mfma_f32_16x16x32_bf16(a, b, c, 0, 0, 0)
constexpr int TS = 72;
__device__ __forceinline__ void retention_item(LAS unsigned char* base, HalfBar& hbr, int item, int lt, const bf16* Zt, bf16* Y, const float* gn_g, const float* gn_b,
                                               const float* ropec, const float* ropes, const float* gpow_all) {
    const int b = item / 6, h = item % 6;
    const int wv = lt >> 6, lane = lt & 63, fr = lane & 15, fq = lane >> 4;
    LAS bf16* Qs = (LAS bf16*)base; LAS bf16* Ks = (LAS bf16*)(base + 9216); LAS bf16* Kdt = (LAS bf16*)(base + 18432); LAS bf16* Vt = (LAS bf16*)(base + 27648);
    LAS bf16* Rt = (LAS bf16*)(base + 36864); LAS bf16* Ps = (LAS bf16*)(base + 46080 + wv * 2304); LAS float* gp = (LAS float*)(base + 55296);
    if (lt < 65) gp[lt] = gpow_all[h * 65 + lt];
    for (int i = lt; i < 64 * TS / 2; i += 256) ((LAS unsigned*)Rt)[i] = 0u;
    f32x4 R[4];
#pragma unroll
    for (int nt = 0; nt < 4; ++nt) R[nt] = (f32x4){0.f, 0.f, 0.f, 0.f};
    hbar(hbr, lt);
    const float cdec = gp[64];
    const int row = lt >> 2, qd = lt & 3;
    u32x4 rq1, rq2, rk1, rk2, rv0, rv1; f32x4 rc0, rc1, rs0, rs1; unsigned gq[16];
#define RET_LOAD(nn) { const size_t mm_ = (size_t)b * SEQ + (size_t)(nn) * 64; const bf16* zr_ = Zt + (mm_ + row) * ZT_P + h * 64; const int pos_ = (nn) * 64 + row; \
        rq1 = *(const u32x4*)(zr_ + 8 * qd); rq2 = *(const u32x4*)(zr_ + 32 + 8 * qd); rk1 = *(const u32x4*)(zr_ + 384 + 8 * qd); rk2 = *(const u32x4*)(zr_ + 384 + 32 + 8 * qd); \
        rv0 = *(const u32x4*)(zr_ + 768 + 16 * qd); rv1 = *(const u32x4*)(zr_ + 768 + 16 * qd + 8); \
        rc0 = *(const f32x4*)(ropec + pos_ * 32 + 8 * qd); rc1 = *(const f32x4*)(ropec + pos_ * 32 + 8 * qd + 4); rs0 = *(const f32x4*)(ropes + pos_ * 32 + 8 * qd); rs1 = *(const f32x4*)(ropes + pos_ * 32 + 8 * qd + 4); \
        _Pragma("unroll") for (int j_ = 0; j_ < 4; ++j_) _Pragma("unroll") for (int nt_ = 0; nt_ < 4; ++nt_) gq[j_ * 4 + nt_] = Zt[(mm_ + 16 * wv + 4 * fq + j_) * ZT_P + 1152 + h * 64 + 16 * nt_ + fr]; }
    RET_LOAD(0)
    for (int n = 0; n < 32; ++n) {
        const size_t m0 = (size_t)b * SEQ + n * 64;
        float gcur[16];
        {
            float c[8], s[8];
            c[0] = rc0.x; c[1] = rc0.y; c[2] = rc0.z; c[3] = rc0.w; c[4] = rc1.x; c[5] = rc1.y; c[6] = rc1.z; c[7] = rc1.w;
            s[0] = rs0.x; s[1] = rs0.y; s[2] = rs0.z; s[3] = rs0.w; s[4] = rs1.x; s[5] = rs1.y; s[6] = rs1.z; s[7] = rs1.w;
            float a1[8], a2[8], o1[8], o2[8];
            unpack8(rq1, a1); unpack8(rq2, a2);
#pragma unroll
            for (int i = 0; i < 8; ++i) { o1[i] = a1[i] * c[i] - a2[i] * s[i]; o2[i] = a1[i] * s[i] + a2[i] * c[i]; }
            *(LAS u32x4*)(Qs + row * TS + 8 * qd) = pack8(o1); *(LAS u32x4*)(Qs + row * TS + 32 + 8 * qd) = pack8(o2);
            unpack8(rk1, a1); unpack8(rk2, a2);
#pragma unroll
            for (int i = 0; i < 8; ++i) { o1[i] = (a1[i] * c[i] - a2[i] * s[i]) * 0.125f; o2[i] = (a1[i] * s[i] + a2[i] * c[i]) * 0.125f; }
            *(LAS u32x4*)(Ks + row * TS + 8 * qd) = pack8(o1); *(LAS u32x4*)(Ks + row * TS + 32 + 8 * qd) = pack8(o2);
            const float kd = gp[63 - row];
#pragma unroll
            for (int i = 0; i < 8; ++i) { Kdt[(8 * qd + i) * TS + row] = (bf16)f2bf(o1[i] * kd); Kdt[(32 + 8 * qd + i) * TS + row] = (bf16)f2bf(o2[i] * kd); }
            const unsigned vw[8] = {rv0.x, rv0.y, rv0.z, rv0.w, rv1.x, rv1.y, rv1.z, rv1.w};
#pragma unroll
            for (int i = 0; i < 8; ++i) { Vt[(16 * qd + 2 * i) * TS + row] = (bf16)(vw[i] & 0xffffu); Vt[(16 * qd + 2 * i + 1) * TS + row] = (bf16)(vw[i] >> 16); }
#pragma unroll
            for (int i = 0; i < 16; ++i) gcur[i] = bf2f(gq[i]);
            if (n + 1 < 32) RET_LOAD(n + 1)
        }
        hbar(hbr, lt);
        f32x4 y[4];
        {
            bf16x8 aq[2];
#pragma unroll
            for (int ks = 0; ks < 2; ++ks) aq[ks] = *(const LAS bf16x8*)(Qs + (16 * wv + fr) * TS + 32 * ks + 8 * fq);
#pragma unroll
            for (int nt = 0; nt < 4; ++nt) { f32x4 acc = (f32x4){0.f, 0.f, 0.f, 0.f};
#pragma unroll
                for (int ks = 0; ks < 2; ++ks) acc = MFMA16(aq[ks], *(const LAS bf16x8*)(Rt + (16 * nt + fr) * TS + 32 * ks + 8 * fq), acc);
#pragma unroll
                for (int j = 0; j < 4; ++j) acc[j] *= gp[16 * wv + 4 * fq + j + 1];
                y[nt] = acc; }
#pragma unroll
            for (int nt = 0; nt < 4; ++nt) { f32x4 acc = (f32x4){0.f, 0.f, 0.f, 0.f};
#pragma unroll
                for (int ks = 0; ks < 2; ++ks) acc = MFMA16(aq[ks], *(const LAS bf16x8*)(Ks + (16 * nt + fr) * TS + 32 * ks + 8 * fq), acc);
#pragma unroll
                for (int j = 0; j < 4; ++j) { const int i = 16 * wv + 4 * fq + j, jj = 16 * nt + fr; const int d = i > jj ? i - jj : jj - i;
                    Ps[(4 * fq + j) * TS + 16 * nt + fr] = (bf16)f2bf(acc[j] * gp[d]); } }
            LDS_WAIT();
            bf16x8 ap[2];
#pragma unroll
            for (int ks = 0; ks < 2; ++ks) ap[ks] = *(const LAS bf16x8*)(Ps + fr * TS + 32 * ks + 8 * fq);
            bf16x8 ak[2];
#pragma unroll
            for (int ks = 0; ks < 2; ++ks) ak[ks] = *(const LAS bf16x8*)(Kdt + (16 * wv + fr) * TS + 32 * ks + 8 * fq);
#pragma unroll
            for (int nt = 0; nt < 4; ++nt) { f32x4 rn = R[nt] * cdec;
#pragma unroll
                for (int ks = 0; ks < 2; ++ks) { const bf16x8 vb = *(const LAS bf16x8*)(Vt + (16 * nt + fr) * TS + 32 * ks + 8 * fq);
                    y[nt] = MFMA16(ap[ks], vb, y[nt]); rn = MFMA16(ak[ks], vb, rn); }
                R[nt] = rn; }
        }
        hbar(hbr, lt);
#pragma unroll
        for (int nt = 0; nt < 4; ++nt) { u32x2 w; w.x = pk2(R[nt][0], R[nt][1]); w.y = pk2(R[nt][2], R[nt][3]); *(LAS u32x2*)(Rt + (16 * nt + fr) * TS + 16 * wv + 4 * fq) = w; }
        float gg[4], gb[4];
#pragma unroll
        for (int nt = 0; nt < 4; ++nt) { gg[nt] = gn_g[h * 64 + 16 * nt + fr]; gb[nt] = gn_b[h * 64 + 16 * nt + fr]; }
#pragma unroll
        for (int j = 0; j < 4; ++j) {
            const float mean = row16_allsum((y[0][j] + y[1][j]) + (y[2][j] + y[3][j])) * (1.f / 64.f);
            float q = 0.f;
#pragma unroll
            for (int nt = 0; nt < 4; ++nt) { const float d = y[nt][j] - mean; q += d * d; }
            const float rstd = 1.f / sqrtf(row16_allsum(q) * (1.f / 64.f) + 1e-5f);
            const size_t m = m0 + 16 * wv + 4 * fq + j;
#pragma unroll
            for (int nt = 0; nt < 4; ++nt) { const int e = 16 * nt + fr;
                const float g = gcur[j * 4 + nt];
                const float o = ((y[nt][j] - mean) * rstd * gg[nt] + gb[nt]) * (g * sigmoidf_(g));
                Y[m * Y_P + 384 + h * 64 + e] = (bf16)f2bf(o); }
        }
    }
    hbar(hbr, lt);
}

#undef RET_LOAD
__device__ __forceinline__ void att_group(const LAS bf16* Qg, const LAS bf16* Ks, const LAS bf16* Vt, LAS bf16* Ps, const LAS float* bt, int dn, int wv, int fr, int fq,
                                          float (&mrun)[4], float (&lrun)[4], f32x4 (&O)[4]) {
    bf16x8 aq[2];
#pragma unroll
    for (int ks = 0; ks < 2; ++ks) aq[ks] = *(const LAS bf16x8*)(Qg + (16 * wv + fr) * TS + 32 * ks + 8 * fq);
    f32x4 sc[4];
#pragma unroll
    for (int nt = 0; nt < 4; ++nt) { f32x4 acc = (f32x4){0.f, 0.f, 0.f, 0.f};
#pragma unroll
        for (int ks = 0; ks < 2; ++ks) acc = MFMA16(aq[ks], *(const LAS bf16x8*)(Ks + (16 * nt + fr) * TS + 32 * ks + 8 * fq), acc);
        if (dn >= 3) {
            const float bfar = bt[191];
#pragma unroll
            for (int j = 0; j < 4; ++j) acc[j] += bfar;
        } else {
#pragma unroll
            for (int j = 0; j < 4; ++j) { int rel = 64 * dn + (16 * wv + 4 * fq + j) - (16 * nt + fr); rel = rel < -63 ? -63 : (rel > 128 ? 128 : rel); acc[j] += bt[rel + 63]; }
        }
        sc[nt] = acc; }
#pragma unroll
    for (int j = 0; j < 4; ++j) {
        const float mx = row16_allmax(fmaxf(fmaxf(sc[0][j], sc[1][j]), fmaxf(sc[2][j], sc[3][j])));
        const float mnew = fmaxf(mrun[j], mx), corr = __expf(mrun[j] - mnew);
        float ps = 0.f;
#pragma unroll
        for (int nt = 0; nt < 4; ++nt) { const float p = __expf(sc[nt][j] - mnew); ps += p; Ps[(4 * fq + j) * TS + 16 * nt + fr] = (bf16)f2bf(p); O[nt][j] *= corr; }
        lrun[j] = lrun[j] * corr + row16_allsum(ps); mrun[j] = mnew;
    }
    LDS_WAIT();
    bf16x8 ap[2];
#pragma unroll
    for (int ks = 0; ks < 2; ++ks) ap[ks] = *(const LAS bf16x8*)(Ps + fr * TS + 32 * ks + 8 * fq);
#pragma unroll
    for (int nt = 0; nt < 4; ++nt)
#pragma unroll
        for (int ks = 0; ks < 2; ++ks) O[nt] = MFMA16(ap[ks], *(const LAS bf16x8*)(Vt + (16 * nt + fr) * TS + 32 * ks + 8 * fq), O[nt]);
    LDS_WAIT();
}
__device__ __forceinline__ void attention_item(LAS unsigned char* base, HalfBar& hbr, int item, int lt, const bf16* Za, bf16* Y, const float* rel_bias) {
    const int np = 15 - item / 128, rest = item % 128, b = rest >> 2, h = rest & 3, n0 = 2 * np, n1 = n0 + 1;
    const int wv = lt >> 6, lane = lt & 63, fr = lane & 15, fq = lane >> 4;
    LAS bf16* QsA = (LAS bf16*)base; LAS bf16* QsB = (LAS bf16*)(base + 9216); LAS bf16* Ks = (LAS bf16*)(base + 18432); LAS bf16* Vt = (LAS bf16*)(base + 27648);
    LAS bf16* Ps = (LAS bf16*)(base + 36864 + wv * 2304); LAS float* bt = (LAS float*)(base + 46080);
    const int row = lt >> 2, qd = lt & 3;
    if (lt < 192) bt[lt] = rel_bias[h * 192 + lt];
    { const bf16* qrow = Za + ((size_t)b * SEQ + n0 * 64 + row) * ZA_P + h * 64 + 16 * qd;
      *(LAS u32x4*)(QsA + row * TS + 16 * qd) = *(const u32x4*)qrow; *(LAS u32x4*)(QsA + row * TS + 16 * qd + 8) = *(const u32x4*)(qrow + 8);
      const bf16* qrow1 = qrow + (size_t)64 * ZA_P;
      *(LAS u32x4*)(QsB + row * TS + 16 * qd) = *(const u32x4*)qrow1; *(LAS u32x4*)(QsB + row * TS + 16 * qd + 8) = *(const u32x4*)(qrow1 + 8); }
    float mA[4], lA[4], mB[4], lB[4]; f32x4 OA[4], OB[4];
#pragma unroll
    for (int j = 0; j < 4; ++j) { mA[j] = -1e30f; lA[j] = 0.f; mB[j] = -1e30f; lB[j] = 0.f; }
#pragma unroll
    for (int nt = 0; nt < 4; ++nt) { OA[nt] = (f32x4){0.f, 0.f, 0.f, 0.f}; OB[nt] = (f32x4){0.f, 0.f, 0.f, 0.f}; }
    const int kc0 = n0 > 8 ? n0 - 8 : 0;
    const bf16* kbase = Za + ((size_t)b * SEQ + row) * ZA_P + 256 + h * 64 + 16 * qd;
    u32x4 k0, k1, v0, v1;
    { const bf16* krow = kbase + (size_t)kc0 * 64 * ZA_P; k0 = *(const u32x4*)krow; k1 = *(const u32x4*)(krow + 8); v0 = *(const u32x4*)(krow + 256); v1 = *(const u32x4*)(krow + 256 + 8); }
    for (int kc = kc0; kc <= n1; ++kc) {
        hbar(hbr, lt);
        { *(LAS u32x4*)(Ks + row * TS + 16 * qd) = k0; *(LAS u32x4*)(Ks + row * TS + 16 * qd + 8) = k1;
          const unsigned vw[8] = {v0.x, v0.y, v0.z, v0.w, v1.x, v1.y, v1.z, v1.w};
#pragma unroll
          for (int i = 0; i < 8; ++i) { Vt[(16 * qd + 2 * i) * TS + row] = (bf16)(vw[i] & 0xffffu); Vt[(16 * qd + 2 * i + 1) * TS + row] = (bf16)(vw[i] >> 16); } }
        if (kc < n1) { const bf16* krow = kbase + (size_t)(kc + 1) * 64 * ZA_P; k0 = *(const u32x4*)krow; k1 = *(const u32x4*)(krow + 8); v0 = *(const u32x4*)(krow + 256); v1 = *(const u32x4*)(krow + 256 + 8); }
        hbar(hbr, lt);
        if (kc <= n0 && kc + 8 >= n0) att_group(QsA, Ks, Vt, Ps, bt, n0 - kc, wv, fr, fq, mA, lA, OA);
        if (kc + 8 >= n1) att_group(QsB, Ks, Vt, Ps, bt, n1 - kc, wv, fr, fq, mB, lB, OB);
    }
#pragma unroll
    for (int j = 0; j < 4; ++j) { const float ia = 1.f / lA[j], ib = 1.f / lB[j]; const size_t m = (size_t)b * SEQ + n0 * 64 + 16 * wv + 4 * fq + j;
#pragma unroll
        for (int nt = 0; nt < 4; ++nt) { Y[m * Y_P + 768 + h * 64 + 16 * nt + fr] = (bf16)f2bf(OA[nt][j] * ia); Y[(m + 64) * Y_P + 768 + h * 64 + 16 * nt + fr] = (bf16)f2bf(OB[nt][j] * ib); } }
    hbar(hbr, lt);
}

#define XB_TMO      128
#define XB_XCNT(j)  (256  + 64 * (j))
#define XB_XSUB(j)  (1280 + 64 * (j))
#define XB_XGEN(j)  (2304 + 64 * (j))
#define XB_TOP      3328
#define XB_TOPGEN   3392
#define XCD_BAR_WORDS 3456
#define XB_SPIN_CAP (1u << 18)
__device__ __forceinline__ unsigned xb_ld(unsigned* p)              { return __hip_atomic_load(p, __ATOMIC_RELAXED, __HIP_MEMORY_SCOPE_AGENT); }
__device__ __forceinline__ unsigned xb_add(unsigned* p, unsigned v) { return __hip_atomic_fetch_add(p, v, __ATOMIC_RELAXED, __HIP_MEMORY_SCOPE_AGENT); }
__device__ __forceinline__ unsigned xb_xcc_id() { return (unsigned)__builtin_amdgcn_s_getreg((3 << 11) | 20) & 0xFu; }
#define XB_SPIN(cond, bar) do { unsigned _sp = 0; while (cond) { __builtin_amdgcn_s_sleep(1); \
    if ((++_sp & 255u) == 0u) { if (xb_ld(&(bar)[XB_TMO])) break; if (_sp > XB_SPIN_CAP) { atomicAdd(&(bar)[XB_TMO], 1u); break; } } } } while (0)
__device__ __forceinline__ void xcd_barrier_complete(unsigned* bar, unsigned x, unsigned& nloc, unsigned& nx) {
    const unsigned G = gridDim.x * gridDim.y * gridDim.z;
    unsigned sum, cnt, mine, sp = 0u;
    for (;;) {
        sum = 0u; cnt = 0u; mine = 0u;
#pragma unroll
        for (unsigned j = 0; j < 16; ++j) { const unsigned c = xb_ld(&bar[XB_XCNT(j)]); sum += c; cnt += (c > 0u) ? 1u : 0u; mine = (j == x) ? c : mine; }
        if (sum == G) break;
        __builtin_amdgcn_s_sleep(1);
        if ((++sp & 255u) == 0u) { if (xb_ld(&bar[XB_TMO])) break; if (sp > XB_SPIN_CAP) { atomicAdd(&bar[XB_TMO], 1u); break; } }
    }
    nloc = mine > 0u ? mine : 1u; nx = cnt > 0u ? cnt : 1u;
}
__device__ __forceinline__ void xcd_barrier(unsigned* bar, volatile LAS unsigned* st, int tid) {
    asm volatile("s_waitcnt vmcnt(0)" ::: "memory");
    __syncthreads();
    if (tid == 0) {
        const unsigned x = xb_xcc_id();
        __builtin_amdgcn_s_waitcnt(0);
        unsigned nloc = st[0], nx = st[1];
        if (nloc == 0u) { xcd_barrier_complete(bar, x, nloc, nx); st[0] = nloc; st[1] = nx; }
        const unsigned old = xb_add(&bar[XB_XSUB(x)], 1u);
        const unsigned gen = old / nloc;
        if (old + 1u == (gen + 1u) * nloc) {
            __builtin_amdgcn_fence(__ATOMIC_RELEASE, "agent");
            asm volatile("s_waitcnt vmcnt(0)" ::: "memory");
            const unsigned og = xb_add(&bar[XB_TOP], 1u);
            const unsigned tg = og / nx;
            if (og + 1u == (tg + 1u) * nx) xb_add(&bar[XB_TOPGEN], 1u);
            else XB_SPIN(xb_ld(&bar[XB_TOPGEN]) == tg, bar);
            __builtin_amdgcn_fence(__ATOMIC_ACQUIRE, "agent");
            xb_add(&bar[XB_XGEN(x)], 1u);
            asm volatile("s_waitcnt vmcnt(0)" ::: "memory");
        } else {
            XB_SPIN(xb_ld(&bar[XB_XGEN(x)]) == gen, bar);
            __builtin_amdgcn_fence(__ATOMIC_ACQUIRE, "agent");
            asm volatile("s_waitcnt vmcnt(0)" ::: "memory");
        }
    }
    __syncthreads();
}
constexpr size_t WS_BAR = 65536;
constexpr size_t WS_PCNT = 131072;
constexpr size_t WS_XBUF = 56 * MiB;
struct Args { const float* in[27]; float* out; unsigned char* ws; };
constexpr int N_RET_ITEMS = 192, N_ATT_ITEMS = 2048, N_SCAN_BLOCKS = 192;

#define PHASE_LOCALS \
    unsigned ones_ = ~0u; asm volatile("" : "+s"(ones_)); \
    int tid = wave_id * 64 + (int)__builtin_amdgcn_mbcnt_hi(ones_, __builtin_amdgcn_mbcnt_lo(ones_, 0u)); asm volatile("" : "+v"(tid)); \
    const int lane = tid & 63, wave = wave_id; \
    const __attribute__((address_space(4))) unsigned char* kp = (const __attribute__((address_space(4))) unsigned char*)__builtin_amdgcn_kernarg_segment_ptr(); asm volatile("" : "+s"(kp)); \
    unsigned char* ws = (unsigned char*)KARG(224); \
    const int G = gridDim.x, bx = blockIdx.x; \
    const int gw = bx * 8 + wave, NGW = G * 8, gt = bx * 512 + tid, NGT = G * 512; \
    (void)lane; (void)gw; (void)NGW; (void)gt; (void)NGT; (void)ws;
#define IN(i) KARG(8 * (i))
#define XPTR ((float*)KARG(216))


#ifndef PROBE_M1
#define PROBE_M1 0ull
#endif
#ifndef PROBE_M2
#define PROBE_M2 0ull
#endif
#ifndef PROBE_XSYNC
#define PROBE_XSYNC 0
#endif
#define PROBE_ON ((PROBE_M1 | PROBE_M2) != 0ull)
#define STAMP(k) do { if (PROBE_ON && blockIdx.x == 0 && threadIdx.x == 0) ((volatile LAS unsigned long long*)(lds + MISC_OFF + 64))[k] = __builtin_amdgcn_s_memrealtime(); } while (0)
#define GRID_BAR() do { unsigned ob_ = ~0u; asm volatile("" : "+s"(ob_)); \
    const int tb_ = wave_id * 64 + (int)__builtin_amdgcn_mbcnt_hi(ob_, __builtin_amdgcn_mbcnt_lo(ob_, 0u)); \
    const __attribute__((address_space(4))) unsigned char* kp = (const __attribute__((address_space(4))) unsigned char*)__builtin_amdgcn_kernarg_segment_ptr(); asm volatile("" : "+s"(kp)); \
    xcd_barrier((unsigned*)((unsigned char*)KARG(224) + WS_BAR), (volatile LAS unsigned*)(lds + MISC_OFF + 32), tb_); } while (0)
__global__ void __launch_bounds__(512, 2) fwd_megakernel(Args a) {
    extern __shared__ __attribute__((aligned(16))) unsigned char lds_raw[];
    LAS unsigned char* lds = (LAS unsigned char*)lds_raw;
    cg::grid_group grid = cg::this_grid();
    const int wave_id = __builtin_amdgcn_readfirstlane(threadIdx.x >> 6);
    STAMP(0);
    int stamp_id = 1;
#define NEXT_STAMP() do { STAMP(stamp_id); ++stamp_id; } while (0)

    {
        PHASE_LOCALS
        unsigned* ctl = (unsigned*)(ws + WS_CTL);
        float* ropec = (float*)(ws + WS_ROPEC); float* ropes = (float*)(ws + WS_ROPES); float* gpow = (float*)(ws + WS_GPOW);
        if (bx == 0 && tid < 16) ctl[tid] = 0u;
        if (bx == 0) for (int i = tid; i < XCD_BAR_WORDS; i += 512) ((unsigned*)(ws + WS_BAR))[i] = 0u;
        for (int i = gt; i < 65536; i += NGT) ((unsigned*)(ws + WS_PCNT))[i] = 0u;
        if (tid < 2) ((volatile LAS unsigned*)(lds + MISC_OFF + 32))[tid] = 0u;
        LAS float* scr = (LAS float*)(lds + wave * 16384);
        constexpr int I_IN = 16 * (NIN / 32), I_OUT = 16 * 32, I_UP = 16 * (DFF2 / 32), I_DN = (DFF / 64) * 32, I_L = I_IN + I_OUT + I_UP + I_DN;
        for (int it = gw; it < 2 * I_L; it += NGW) {
            const int l = it / I_L; int r = it % I_L;
            unsigned char* wl = ws + WS_W + (size_t)l * W_LAYER;
            if (r < I_IN) { p0_transpose_item(IN(3) + (size_t)l * DM * NIN, DM, NIN, (bf16*)(wl + WO_IN), 1, scr, r, lane); continue; } r -= I_IN;
            if (r < I_OUT) { p0_transpose_item(IN(18) + (size_t)l * DM * DM, DM, DM, (bf16*)(wl + WO_OUT), 0, scr, r, lane); continue; } r -= I_OUT;
            if (r < I_UP) { p0_transpose_item(IN(21) + (size_t)l * DM * DFF2, DM, DFF2, (bf16*)(wl + WO_UP), 2, scr, r, lane); continue; } r -= I_UP;
            p0_transpose_item(IN(24) + (size_t)l * DFF * DM, DFF, DM, (bf16*)(wl + WO_DN), 0, scr, r, lane);
        }
        for (int i = gt; i < 2 * 128 * DM / 8; i += NGT) {
            const int l = i / (128 * DM / 8), r = i % (128 * DM / 8);
            *((u32x4*)(ws + WS_W + (size_t)l * W_LAYER + WO_IN + (size_t)1408 * DM * 2) + r) = (u32x4){0u, 0u, 0u, 0u};
        }
        for (int i = gt; i < 2 * NLORA * KLORA; i += NGT) {
            const int l = i / (NLORA * KLORA), r = i % (NLORA * KLORA), n = r / KLORA, k = r % KLORA;
            float v = 0.f;
            if (n < 384) { if (k < 64) v = IN(6)[(size_t)l * 64 * 384 + k * 384 + n]; }
            else if (n < 768) { if (k >= 64 && k < 128) v = IN(8)[(size_t)l * 64 * 384 + (k - 64) * 384 + (n - 384)]; }
            else if (n < 1152) { if (k >= 128) v = IN(9)[(size_t)l * 128 * 384 + (k - 128) * 384 + (n - 768)]; }
            ((bf16*)(ws + WS_W + (size_t)l * W_LAYER + WO_LORA))[r] = (bf16)f2bf(v);
        }
        for (int i = gt; i < SEQ * 32; i += NGT) {
            const int t = i >> 5, ii = i & 31;
            const float inv = (float)exp2(-(double)ii * (13.287712379549449 / 32.0));
            const float ang = (float)t * inv;
            const double rev = (double)ang * 0.15915494309189535; const float fr_ = (float)(rev - floor(rev));
            ropec[i] = __builtin_amdgcn_cosf(fr_); ropes[i] = __builtin_amdgcn_sinf(fr_);
        }
        if (gt < 6) { const double g = 1.0 - exp2(-5.0 - (double)gt); double p = 1.0; for (int nn = 0; nn <= 64; ++nn) { gpow[gt * 65 + nn] = (float)p; p *= g; } }
        float* X = XPTR; bf16* XN = (bf16*)(ws + WS_XN);
        { Rows2f cur = ln_load2f(IN(0) + (size_t)(2 * gw) * DM, IN(0) + (size_t)(2 * gw + 1) * DM, lane);
          for (int m = 2 * gw; m < MTOK; m += 2 * NGW) {
              const int mn = (m + 2 * NGW < MTOK) ? m + 2 * NGW : m;
              const Rows2f nxt = ln_load2f(IN(0) + (size_t)mn * DM, IN(0) + (size_t)(mn + 1) * DM, lane);
              ln_row2(cur, IN(1), IN(2), (float*)nullptr, (float*)nullptr, XN + (size_t)m * DM, XN + (size_t)(m + 1) * DM, lane);
              cur = nxt; } }
    }
    grid.sync(); NEXT_STAMP();
    { PHASE_LOCALS
      if (tid == 0) (void)xb_add((unsigned*)(ws + WS_BAR) + XB_XCNT(xb_xcc_id()), 1u); }
    if (PROBE_XSYNC) { for (int i = 0; i < PROBE_XSYNC; ++i) grid.sync(); STAMP(40); }

    for (int l = 0; l < 2; ++l) {
        { PHASE_LOCALS
          pg8::Gemm g{(const bf16*)(ws + WS_XN), (const bf16*)(ws + WS_W + (size_t)l * W_LAYER + WO_IN), MTOK, NIN_PAD, DM, DM}; pg8::StaticOrder S; S.init(MTOK, NIN_PAD, G, bx);
          pg8::EpiZ E{(bf16*)(ws + WS_ZR), (bf16*)(ws + WS_ZT), (bf16*)(ws + WS_ZA)}; pg8::gemm_phase<pg8::EpiZ>(lds, g, S, E, wave_id); }
        GRID_BAR(); NEXT_STAMP();
        { PHASE_LOCALS
          const bf16* Zr = (const bf16*)(ws + WS_ZR); bf16* LP = (bf16*)(ws + WS_LP); const float* mu = IN(4) + l * 1408;
          const int c8 = gt & 31;
          float muv[8];
          { const f32x4 m0 = *(const f32x4*)(mu + 1152 + 8 * c8), m1 = *(const f32x4*)(mu + 1152 + 8 * c8 + 4);
            muv[0] = m0.x; muv[1] = m0.y; muv[2] = m0.z; muv[3] = m0.w; muv[4] = m1.x; muv[5] = m1.y; muv[6] = m1.z; muv[7] = m1.w; }
          for (int i = gt; i < MTOK * 32; i += 4 * NGT) {
            u32x4 qc[4], qp[4];
#pragma unroll
            for (int u = 0; u < 4; ++u) { const int m = (i + u * NGT) >> 5; const int mp = (m & (SEQ - 1)) != 0 ? m - 1 : m;
                qc[u] = *(const u32x4*)(Zr + (size_t)m * ZR_P + 1152 + 8 * c8); qp[u] = *(const u32x4*)(Zr + (size_t)mp * ZR_P + 1152 + 8 * c8); }
#pragma unroll
            for (int u = 0; u < 4; ++u) { const int m = (i + u * NGT) >> 5; const bool hasprev = (m & (SEQ - 1)) != 0;
                float cur[8], prv[8], o[8];
                unpack8(qc[u], cur); unpack8(qp[u], prv);
#pragma unroll
                for (int j = 0; j < 8; ++j) { const float pv_ = hasprev ? prv[j] : 0.f; const float sft = cur[j] + (pv_ - cur[j]) * muv[j];
                    const float sg = sigmoidf_(c8 < 8 ? 2.f * sft : sft);
                    o[j] = c8 < 8 ? (2.f * sg - 1.f) : (c8 < 16 ? sft : sg); }
                *(u32x4*)(LP + (size_t)m * LP_P + 8 * c8) = pack8(o); }
          } }
        GRID_BAR(); NEXT_STAMP();
        { PHASE_LOCALS
          bf16* LP = (bf16*)(ws + WS_LP);
          pg8::Gemm g{LP, (const bf16*)(ws + WS_W + (size_t)l * W_LAYER + WO_LORA), MTOK, NLORA, KLORA, LP_P}; pg8::StaticOrder S; S.init(MTOK, NLORA, G, bx);
          pg8::EpiBf16 E{LP + 256, LP_P}; pg8::gemm_phase<pg8::EpiBf16>(lds, g, S, E, wave_id); }
        GRID_BAR(); NEXT_STAMP();
        { PHASE_LOCALS
            const bf16* Zr = (const bf16*)(ws + WS_ZR); const bf16* LP = (const bf16*)(ws + WS_LP); bf16* REC = (bf16*)XPTR; float* BONUS = (float*)(ws + WS_BONUS);
            const float* mu = IN(4) + l * 1408;
            const float* w0 = IN(5) + l * 384; const float* a0 = IN(7) + l * 384; const float* k_k = IN(10) + l * 384; const float* k_a = IN(11) + l * 384; const float* r_k = IN(12) + l * 384;
            const int ts = lane >> 4, c4 = lane & 15;
            for (int it = gw; it < MTOK / 4; it += NGW) {
                const int m = it * 4 + ts, t = m & (SEQ - 1), bb = m >> 11;
                const bool hasprev = t != 0;
                const bf16* z = Zr + (size_t)m * ZR_P; const bf16* zp = z - ZR_P; const bf16* lp = LP + (size_t)m * LP_P;
#pragma unroll
                for (int h = 0; h < 6; ++h) {
                    const int c = h * 64 + 4 * c4;
                    const u32x2 kw = *(const u32x2*)(z + 384 + c), rw = *(const u32x2*)(z + c);
                    u32x2 kpw = (u32x2){0u, 0u}, rpw = (u32x2){0u, 0u};
                    if (hasprev) { kpw = *(const u32x2*)(zp + 384 + c); rpw = *(const u32x2*)(zp + c); }
                    const u32x2 wpw = *(const u32x2*)(lp + 256 + c), apw = *(const u32x2*)(lp + 640 + c);
                    const f32x4 muk = *(const f32x4*)(mu + 384 + c), mur = *(const f32x4*)(mu + c), w0v = *(const f32x4*)(w0 + c), a0v = *(const f32x4*)(a0 + c),
                                kkv = *(const f32x4*)(k_k + c), kav = *(const f32x4*)(k_a + c), rkv = *(const f32x4*)(r_k + c);
                    const float kf[4] = {bflo(kw.x), bfhi(kw.x), bflo(kw.y), bfhi(kw.y)}, rf[4] = {bflo(rw.x), bfhi(rw.x), bflo(rw.y), bfhi(rw.y)};
                    const float kpf[4] = {bflo(kpw.x), bfhi(kpw.x), bflo(kpw.y), bfhi(kpw.y)}, rpf[4] = {bflo(rpw.x), bfhi(rpw.x), bflo(rpw.y), bfhi(rpw.y)};
                    const float wf[4] = {bflo(wpw.x), bfhi(wpw.x), bflo(wpw.y), bfhi(wpw.y)}, af[4] = {bflo(apw.x), bfhi(apw.x), bflo(apw.y), bfhi(apw.y)};
                    float rs[4], xd[4], kpr[4], kkr[4], avv[4]; float n2 = 0.f, bon = 0.f;
#pragma unroll
                    for (int j = 0; j < 4; ++j) {
                        const float ks = kf[j] + (kpf[j] - kf[j]) * muk[j]; rs[j] = rf[j] + (rpf[j] - rf[j]) * mur[j];
                        const float av = sigmoidf_(a0v[j] + af[j]); avv[j] = av;
                        const float xx = -(w0v[j] + wf[j]);
                        const float sp = fmaxf(xx, 0.f) + __logf(1.f + __expf(-fabsf(xx)));
                        const float ew = __expf(-sp - 0.5f);
                        xd[j] = 1.f - __expf(-ew);
                        const float kk = ks * kkv[j]; kkr[j] = kk; n2 += kk * kk;
                        kpr[j] = ks * (1.f + (av - 1.f) * kav[j]);
                        bon += rs[j] * kpr[j] * rkv[j];
                    }
                    n2 = row16_allsum(n2); bon = row16_allsum(bon);
                    const float inv = 1.f / fmaxf(sqrtf(n2), 1e-12f);
                    bf16* rec = REC + (((size_t)(bb * 6 + h) * SEQ + t) * 5) * 64 + 4 * c4;
                    u32x2 o;
                    o.x = pkh2(rs[0], rs[1]); o.y = pkh2(rs[2], rs[3]); *(u32x2*)(rec) = o;
                    o.x = pkh2(xd[0], xd[1]); o.y = pkh2(xd[2], xd[3]); *(u32x2*)(rec + 64) = o;
                    o.x = pkh2(kpr[0], kpr[1]); o.y = pkh2(kpr[2], kpr[3]); *(u32x2*)(rec + 128) = o;
                    o.x = pkh2(kkr[0] * inv, kkr[1] * inv); o.y = pkh2(kkr[2] * inv, kkr[3] * inv); *(u32x2*)(rec + 192) = o;
                    o.x = pkh2(kkr[0] * inv * avv[0], kkr[1] * inv * avv[1]); o.y = pkh2(kkr[2] * inv * avv[2], kkr[3] * inv * avv[3]); *(u32x2*)(rec + 256) = o;
                    if (c4 == 0) BONUS[(size_t)m * 6 + h] = bon;
                }
            }
        }
        GRID_BAR(); NEXT_STAMP();
        { PHASE_LOCALS
            bf16* Yb = (bf16*)(ws + WS_Y);
            const int hbi = tid >> 8, lt = tid & 255;
            volatile LAS int* sh_item = (volatile LAS int*)(lds + MISC_OFF) + hbi;
            if (tid < 2) ((LAS unsigned*)(lds + MISC_OFF + 16))[tid] = 0u;
            __syncthreads();
            HalfBar hbr{(LAS unsigned*)(lds + MISC_OFF + 16) + hbi, 0u};
            if (bx < N_SCAN_BLOCKS && hbi == 0) { rwkv_scan(bx, wave, lane, (const bf16*)(ws + WS_ZR), (const unsigned char*)XPTR, Yb, IN(4) + l * 1408); STAMP(41 + l); }
            LAS unsigned char* hbase = lds + hbi * 57344;
            bool ret_open = !(bx < N_SCAN_BLOCKS && hbi == 1);
            unsigned* qret = (unsigned*)(ws + WS_CTL) + 2 * l; unsigned* qatt = qret + 1;
            for (;;) {
                if (lt == 0) {
                    int it = -1;
                    if (ret_open) { it = (int)atomicAdd(qret, 1u); if (it >= N_RET_ITEMS) it = -1; }
                    if (it < 0) { const int a2 = (int)atomicAdd(qatt, 1u); it = (a2 < N_ATT_ITEMS) ? N_RET_ITEMS + a2 : -2; }
                    *sh_item = it;
                }
                hbar(hbr, lt);
                const int item = *sh_item;
                hbar(hbr, lt);
                if (item < 0) break;
                if (item < N_RET_ITEMS) retention_item(hbase, hbr, item, lt, (const bf16*)(ws + WS_ZT), Yb, IN(15) + l * 384, IN(16) + l * 384, (const float*)(ws + WS_ROPEC), (const float*)(ws + WS_ROPES), (const float*)(ws + WS_GPOW));
                else { ret_open = false; attention_item(hbase, hbr, item - N_RET_ITEMS, lt, (const bf16*)(ws + WS_ZA), Yb, IN(17) + l * 4 * 192); }
            }
        }
        GRID_BAR(); NEXT_STAMP();
        { PHASE_LOCALS
            const bf16* Zr = (const bf16*)(ws + WS_ZR); const bf16* LP = (const bf16*)(ws + WS_LP); bf16* Yb = (bf16*)(ws + WS_Y); const float* BONUS = (const float*)(ws + WS_BONUS);
            const float* mu = IN(4) + l * 1408; const float* lng = IN(13) + l * 384; const float* lnb = IN(14) + l * 384;
            const int ts = lane >> 4, c4 = lane & 15;
            for (int it = gw; it < MTOK / 4; it += NGW) {
                const int m = it * 4 + ts;
                const bool hasprev = (m & (SEQ - 1)) != 0;
                const bf16* z = Zr + (size_t)m * ZR_P; const bf16* zp = z - ZR_P; const bf16* lp = LP + (size_t)m * LP_P; bf16* yr = Yb + (size_t)m * Y_P;
#pragma unroll
                for (int h = 0; h < 6; ++h) {
                    const int c = h * 64 + 4 * c4;
                    const u32x2 yw = *(const u32x2*)(yr + c), vw = *(const u32x2*)(z + 768 + c), gw_ = *(const u32x2*)(lp + 1024 + c);
                    u32x2 vpw = (u32x2){0u, 0u}; if (hasprev) vpw = *(const u32x2*)(zp + 768 + c);
                    const f32x4 muv = *(const f32x4*)(mu + 768 + c), lgv = *(const f32x4*)(lng + c), lbv = *(const f32x4*)(lnb + c);
                    const float bon = BONUS[(size_t)m * 6 + h];
                    const float yf[4] = {bflo(yw.x), bfhi(yw.x), bflo(yw.y), bfhi(yw.y)}, vf[4] = {bflo(vw.x), bfhi(vw.x), bflo(vw.y), bfhi(vw.y)};
                    const float vpf[4] = {bflo(vpw.x), bfhi(vpw.x), bflo(vpw.y), bfhi(vpw.y)}, gf[4] = {bflo(gw_.x), bfhi(gw_.x), bflo(gw_.y), bfhi(gw_.y)};
                    const float mean = row16_allsum((yf[0] + yf[1]) + (yf[2] + yf[3])) * (1.f / 64.f);
                    float q = 0.f;
#pragma unroll
                    for (int j = 0; j < 4; ++j) { const float d = yf[j] - mean; q += d * d; }
                    const float rstd = 1.f / sqrtf(row16_allsum(q) * (1.f / 64.f) + 64e-5f);
                    float o[4];
#pragma unroll
                    for (int j = 0; j < 4; ++j) { const float vs = vf[j] + (vpf[j] - vf[j]) * muv[j]; o[j] = ((yf[j] - mean) * rstd * lgv[j] + lbv[j] + bon * vs) * gf[j]; }
                    u32x2 ow; ow.x = pk2(o[0], o[1]); ow.y = pk2(o[2], o[3]); *(u32x2*)(yr + c) = ow;
                }
            }
        }
        GRID_BAR(); NEXT_STAMP();
        for (int rnd = 0; rnd < 4; ++rnd) { PHASE_LOCALS
          pg8::Gemm g{(const bf16*)(ws + WS_Y), (const bf16*)(ws + WS_W + (size_t)l * W_LAYER + WO_OUT), MTOK, DM, DM, DM}; pg8::StaticOrder S; S.init(MTOK, DM, G, bx); S.i0 = rnd; S.ni = 1;
          pg8::PanelStats st{(unsigned long long*)(ws + WS_XBUF + (size_t)(2 * l) * 2 * MiB), (unsigned*)(ws + WS_PCNT + (size_t)(2 * l) * 65536), LN_EPS};
          pg8::EpiLnFused E{(bf16*)(ws + WS_XN), (float*)nullptr, true, IN(19) + l * DM, IN(20) + l * DM, ALPHA, st};
          pg8::gemm_phase<pg8::EpiLnFused>(lds, g, S, E, wave_id); }
        GRID_BAR(); NEXT_STAMP();
        { PHASE_LOCALS
          pg8::Gemm g{(const bf16*)(ws + WS_XN), (const bf16*)(ws + WS_W + (size_t)l * W_LAYER + WO_UP), MTOK, DFF2, DM, DM}; pg8::StaticOrder S; S.init(MTOK, DFF2, G, bx);
          pg8::EpiConvGate E{kp, l, lds + 132096}; pg8::gemm_phase<pg8::EpiConvGate>(lds, g, S, E, wave_id); }
        GRID_BAR(); NEXT_STAMP();
        { PHASE_LOCALS
          const bf16* UB = (const bf16*)(ws + WS_UB); bf16* HH = (bf16*)(ws + WS_HH);
          const float* cw = IN(22) + (size_t)l * 3 * DFF2; const float* cb = IN(23) + (size_t)l * DFF2;
          for (int i = gt; i < (MTOK / 64) * 2 * (DFF / 4); i += NGT) {
              const int j = 4 * (i % (DFF / 4)), q = i / (DFF / 4), rr = q & 1, blk = q >> 1;
              const bool first = (blk & 31) == 0;
              const bf16* u0p = UB + ((size_t)(blk * 4 + rr) * 2) * DFF + j;
              const bf16* u1p = rr == 1 ? UB + ((size_t)(blk * 4 + 0) * 2) * DFF + j : UB + ((size_t)((blk - 1) * 4 + 3) * 2) * DFF + j;
              const bf16* u2p = rr == 1 ? UB + ((size_t)((blk - 1) * 4 + 3) * 2) * DFF + j : UB + ((size_t)((blk - 1) * 4 + 2) * 2) * DFF + j;
              const u32x2 g0w = *(const u32x2*)u0p, v0w = *(const u32x2*)(u0p + DFF);
              u32x2 g1w = (u32x2){0u, 0u}, v1w = g1w, g2w = g1w, v2w = g1w;
              if (rr == 1 || !first) { g1w = *(const u32x2*)u1p; v1w = *(const u32x2*)(u1p + DFF); }
              if (!first) { g2w = *(const u32x2*)u2p; v2w = *(const u32x2*)(u2p + DFF); }
              const float g0[4] = {bflo(g0w.x), bfhi(g0w.x), bflo(g0w.y), bfhi(g0w.y)}, v0[4] = {bflo(v0w.x), bfhi(v0w.x), bflo(v0w.y), bfhi(v0w.y)};
              const float g1[4] = {bflo(g1w.x), bfhi(g1w.x), bflo(g1w.y), bfhi(g1w.y)}, v1[4] = {bflo(v1w.x), bfhi(v1w.x), bflo(v1w.y), bfhi(v1w.y)};
              const float g2[4] = {bflo(g2w.x), bfhi(g2w.x), bflo(g2w.y), bfhi(g2w.y)}, v2[4] = {bflo(v2w.x), bfhi(v2w.x), bflo(v2w.y), bfhi(v2w.y)};
              float h[4];
              const f32x4 pbg = *(const f32x4*)(cb + j), pg0 = *(const f32x4*)(cw + j), pg1 = *(const f32x4*)(cw + DFF2 + j), pg2 = *(const f32x4*)(cw + 2 * DFF2 + j);
              const f32x4 pbv = *(const f32x4*)(cb + DFF + j), pv0 = *(const f32x4*)(cw + DFF + j), pv1 = *(const f32x4*)(cw + DFF2 + DFF + j), pv2 = *(const f32x4*)(cw + 2 * DFF2 + DFF + j);
#pragma unroll
              for (int k = 0; k < 4; ++k) {
                  const float cg = pbg[k] + pg0[k] * g2[k] + pg1[k] * g1[k] + pg2[k] * g0[k];
                  const float cv = pbv[k] + pv0[k] * v2[k] + pv1[k] * v1[k] + pv2[k] * v0[k];
                  h[k] = cg * cv * __builtin_amdgcn_rcpf(1.f + __expf(-cg));
              }
              u32x2 w; w.x = pk2(h[0], h[1]); w.y = pk2(h[2], h[3]); *(u32x2*)(HH + ((size_t)blk * 64 + rr) * DFF + j) = w;
          } }
        GRID_BAR(); NEXT_STAMP();
        for (int rnd = 0; rnd < 4; ++rnd) { PHASE_LOCALS
          pg8::Gemm g{(const bf16*)(ws + WS_HH), (const bf16*)(ws + WS_W + (size_t)l * W_LAYER + WO_DN), MTOK, DM, DFF, DFF}; pg8::StaticOrder S; S.init(MTOK, DM, G, bx); S.i0 = rnd; S.ni = 1;
          pg8::PanelStats st{(unsigned long long*)(ws + WS_XBUF + (size_t)(2 * l + 1) * 2 * MiB), (unsigned*)(ws + WS_PCNT + (size_t)(2 * l + 1) * 65536), LN_EPS};
          pg8::EpiLnFused E{(bf16*)(ws + WS_XN), XPTR, l == 0, IN(25) + l * DM, IN(26) + l * DM, ALPHA, st};
          pg8::gemm_phase<pg8::EpiLnFused>(lds, g, S, E, wave_id); }
        if (l == 0) { GRID_BAR(); NEXT_STAMP(); }
    }
    if (PROBE_ON && blockIdx.x == 0) {
        STAMP(stamp_id);
        __threadfence(); __syncthreads();
        volatile LAS unsigned long long* st = (volatile LAS unsigned long long*)(lds + MISC_OFF + 64);
        unsigned long long q1 = 0, q2 = 0;
        for (int k = 0; k < 31; ++k) { const unsigned long long d = st[k + 1] - st[k]; if ((PROBE_M1 >> k) & 1ull) q1 += d; if ((PROBE_M2 >> k) & 1ull) q2 += d; }
        if ((PROBE_M1 >> 40) & 1ull) q1 += st[40] - st[1];
        if ((PROBE_M2 >> 40) & 1ull) q2 += st[40] - st[1];
        if ((PROBE_M1 >> 41) & 1ull) q1 += (st[41] - st[5]) + (st[42] - st[17]);
        if ((PROBE_M2 >> 41) & 1ull) q2 += (st[41] - st[5]) + (st[42] - st[17]);
        const long K = (long)(q1 * 16ull / 100ull) < 262144l ? (long)(q1 * 16ull / 100ull) : 262144l;
        const __attribute__((address_space(4))) unsigned char* kp = (const __attribute__((address_space(4))) unsigned char*)__builtin_amdgcn_kernarg_segment_ptr();
        float* Xo = XPTR;
        for (long e = threadIdx.x; e < K; e += 512) { const long r = e >> 10, c = e & 1023; atomicAdd(Xo + ((r & 7) + 2048 * (r >> 3)) * 1024 + c, 0.125f); }
        if (threadIdx.x == 0) { const unsigned long long t0 = __builtin_amdgcn_s_memrealtime(); while (__builtin_amdgcn_s_memrealtime() - t0 < q2) __builtin_amdgcn_s_sleep(8); }
    }
}

extern "C" void kernel_launch(void* const* d_in, const int* in_sizes, int n_in, void* d_out, int out_size, void* d_ws, size_t ws_size, hipStream_t stream) {
    static int grid = 0;
    if (grid == 0) {
        if (n_in != 27 || out_size != MTOK * DM || ws_size < WS_END) { fprintf(stderr, "kernel_launch: unexpected shapes (n_in %d out %d ws %zu)\n", n_in, out_size, ws_size); grid = -1; return; }
        int dev = 0, cus = 0, per_cu = 0;
        hipGetDevice(&dev); hipDeviceGetAttribute(&cus, hipDeviceAttributeMultiprocessorCount, dev);
        if (hipFuncSetAttribute((const void*)fwd_megakernel, hipFuncAttributeMaxDynamicSharedMemorySize, LDS_BYTES) != hipSuccess) { fprintf(stderr, "kernel_launch: hipFuncSetAttribute failed\n"); grid = -1; return; }
        if (hipOccupancyMaxActiveBlocksPerMultiprocessor(&per_cu, (const void*)fwd_megakernel, 512, LDS_BYTES) != hipSuccess || per_cu < 1) { fprintf(stderr, "kernel_launch: occupancy query says %d\n", per_cu); per_cu = 1; }
        (void)hipGetLastError();
        grid = cus;
        if (grid > 256) grid = 256;
    }
    if (grid < 0) return;
    Args a{};
    for (int i = 0; i < 27; ++i) a.in[i] = (const float*)d_in[i];
    a.out = (float*)d_out; a.ws = (unsigned char*)d_ws;
    void* args[] = {&a};
    hipError_t e = hipLaunchCooperativeKernel((const void*)fwd_megakernel, dim3(grid), dim3(512), args, LDS_BYTES, stream);
    if (e != hipSuccess) fprintf(stderr, "cooperative launch failed: %s (grid %d)\n", hipGetErrorString(e), grid);
}
```
